# Optimizing an MI355X kernel written in HIP

```python
import jax, jax.numpy as jnp
from jax import lax
import numpy as np

D_MODEL = 1024
BATCH = 4
SEQ = 8192
DEPTH = 1

NSA_HEADS = 8
NSA_KV_GROUPS = 2
HEAD_DIM = 64
NSA_WIDTH = NSA_HEADS * HEAD_DIM
KV_WIDTH = NSA_KV_GROUPS * HEAD_DIM
CMP_LEN = 32
CMP_STRIDE = 16
CMP_HIDDEN = 256
SLC_LEN = 64
SLC_TOPK = 16
WINDOW = 512
Q_BLOCK = 128
ROPE_THETA = 10000.0
RWKV_HEADS = 8
RWKV_HEAD = 64
RWKV_WIDTH = RWKV_HEADS * RWKV_HEAD
DECAY_LORA = 32
AAA_LORA = 32
GATE_LORA = 96
LNX_EPS = 64e-5
D_FF = ((-(-8 * D_MODEL // 3) + 255) // 256) * 256
NORM_EPS = 1e-6
BIG = 1e30

SPLIT_SIZES = (NSA_WIDTH, KV_WIDTH, KV_WIDTH, KV_WIDTH, KV_WIDTH, KV_WIDTH, KV_WIDTH, 3 * NSA_HEADS,
               RWKV_WIDTH, RWKV_WIDTH, RWKV_WIDTH, DECAY_LORA, AAA_LORA, GATE_LORA, 2 * D_MODEL)
IN_COLS = sum(SPLIT_SIZES)

kernel_name = 'hybrid_nsa_rwkv7_block'


def _split_points():
    pts, acc = [], 0
    for s in SPLIT_SIZES[:-1]:
        acc += s
        pts.append(acc)
    return pts


def rms_norm(x, g):
    xf = x.astype(jnp.float32)
    y = xf * lax.rsqrt(jnp.mean(xf * xf, axis=-1, keepdims=True) + NORM_EPS)
    return (y * g.astype(jnp.float32)).astype(x.dtype)


def rope_tables(n, dim):
    inv = 1.0 / (ROPE_THETA ** (jnp.arange(0, dim, 2, dtype=jnp.float32) / dim))
    ang = jnp.arange(n, dtype=jnp.float32)[:, None] * inv[None, :]
    return jnp.cos(ang), jnp.sin(ang)


def apply_rope(x, cos, sin):
    x1, x2 = jnp.split(x.astype(jnp.float32), 2, axis=-1)
    c, s = cos[None, :, None, :], sin[None, :, None, :]
    return jnp.concatenate([x1 * c - x2 * s, x1 * s + x2 * c], axis=-1).astype(x.dtype)


def token_shift(z, mu):
    prev = jnp.pad(z, ((0, 0), (1, 0), (0, 0)))[:, :-1]
    return z + (prev - z) * mu


def masked_softmax(s, mask):
    s = jnp.where(mask, s.astype(jnp.float32), -BIG)
    return jnp.where(mask, jax.nn.softmax(s, axis=-1), 0.0)


def compress(z, pe, w1, b1, w2):
    bsz, seq, groups, dim = z.shape
    n_cmp = (seq - CMP_LEN) // CMP_STRIDE + 1
    idx = jnp.arange(n_cmp)[:, None] * CMP_STRIDE + jnp.arange(CMP_LEN)[None, :]
    blk = z[:, idx] + pe[None, None, :, None, :]
    blk = blk.transpose(0, 1, 3, 2, 4).reshape(bsz, n_cmp, groups, CMP_LEN * dim)
    return jax.nn.gelu(blk @ w1 + b1) @ w2


def nsa_attention(q, k_cmp, v_cmp, k_slc, v_slc, k_win, v_win, gate_logits,
                  pe_k, w1_k, b1_k, w2_k, pe_v, w1_v, b1_v, w2_v):
    bsz, seq = q.shape[:2]
    G, R, d = NSA_KV_GROUPS, NSA_HEADS // NSA_KV_GROUPS, HEAD_DIM
    scale = d ** -0.5
    cos, sin = rope_tables(seq, d)

    kc = compress(k_cmp, pe_k, w1_k, b1_k, w2_k)
    vc = compress(v_cmp, pe_v, w1_v, b1_v, w2_v)
    n_cmp = kc.shape[1]
    cmp_start = jnp.arange(n_cmp) * CMP_STRIDE
    cmp_end = cmp_start + CMP_LEN - 1
    n_slc = seq // SLC_LEN
    n_sel = min(SLC_TOPK, n_slc)
    slc_start = jnp.arange(n_slc) * SLC_LEN
    overlap = ((cmp_start[:, None] < slc_start[None, :] + SLC_LEN)
               & (cmp_end[:, None] >= slc_start[None, :])).astype(jnp.float32)

    q_plain = q.reshape(bsz, seq, G, R, d)
    q_rot = apply_rope(q, cos, sin).reshape(bsz, seq, G, R, d)
    k_slc_blk = apply_rope(k_slc, cos, sin).reshape(bsz, n_slc, SLC_LEN, G, d).transpose(0, 3, 1, 2, 4)
    v_slc_blk = v_slc.reshape(bsz, n_slc, SLC_LEN, G, d).transpose(0, 3, 1, 2, 4)
    pad = ((0, 0), (WINDOW, 0), (0, 0), (0, 0))
    k_win_pad = jnp.pad(apply_rope(k_win, cos, sin), pad)
    v_win_pad = jnp.pad(v_win, pad)
    gate = jax.nn.sigmoid(gate_logits).reshape(bsz, seq, 3, G, R)

    b_ix = jnp.arange(bsz)[:, None, None, None]
    g_ix = jnp.arange(G)[None, :, None, None]
    blk_ids = jnp.arange(n_slc)
    in_blk = jnp.arange(SLC_LEN)
    win_off = jnp.arange(WINDOW + Q_BLOCK) - WINDOW

    def query_block(i):
        q0 = i * Q_BLOCK
        t = q0 + jnp.arange(Q_BLOCK)
        qp = lax.dynamic_slice_in_dim(q_plain, q0, Q_BLOCK, 1)
        qr = lax.dynamic_slice_in_dim(q_rot, q0, Q_BLOCK, 1)
        gb = lax.dynamic_slice_in_dim(gate, q0, Q_BLOCK, 1)

        s_c = jnp.einsum('bqgrd,bngd->bgrqn', qp, kc) * scale
        p_c = masked_softmax(s_c, cmp_end[None, :] <= t[:, None])
        o_c = jnp.einsum('bgrqn,bngd->bqgrd', p_c.astype(vc.dtype), vc)

        imp = jnp.einsum('bgrqn,nj->bgqj', p_c, overlap)
        cur = (t // SLC_LEN)[:, None]
        imp = jnp.where(blk_ids[None, :] > cur, -BIG, imp)
        imp = jnp.where((blk_ids[None, :] == 0) | (blk_ids[None, :] == cur), BIG, imp)
        _, sel = lax.top_k(imp, n_sel)

        k_sel = k_slc_blk[b_ix, g_ix, sel].reshape(bsz, G, Q_BLOCK, n_sel * SLC_LEN, d)
        v_sel = v_slc_blk[b_ix, g_ix, sel].reshape(bsz, G, Q_BLOCK, n_sel * SLC_LEN, d)
        pos = (sel[..., None] * SLC_LEN + in_blk).reshape(bsz, G, Q_BLOCK, n_sel * SLC_LEN)
        s_s = jnp.einsum('bqgrd,bgqkd->bgrqk', qr, k_sel) * scale
        p_s = masked_softmax(s_s, (pos <= t[:, None])[:, :, None])
        o_s = jnp.einsum('bgrqk,bgqkd->bqgrd', p_s.astype(v_sel.dtype), v_sel)

        k_w = lax.dynamic_slice_in_dim(k_win_pad, q0, WINDOW + Q_BLOCK, 1)
        v_w = lax.dynamic_slice_in_dim(v_win_pad, q0, WINDOW + Q_BLOCK, 1)
        kpos = q0 + win_off
        m_w = ((kpos[None, :] <= t[:, None]) & (kpos[None, :] > t[:, None] - WINDOW)
               & (kpos[None, :] >= 0))
        s_w = jnp.einsum('bqgrd,bkgd->bgrqk', qr, k_w) * scale
        p_w = masked_softmax(s_w, m_w)
        o_w = jnp.einsum('bgrqk,bkgd->bqgrd', p_w.astype(v_w.dtype), v_w)

        o = (gb[:, :, 0, :, :, None] * o_c + gb[:, :, 1, :, :, None] * o_s
             + gb[:, :, 2, :, :, None] * o_w)
        return o.reshape(bsz, Q_BLOCK, NSA_WIDTH)

    out = lax.map(query_block, jnp.arange(seq // Q_BLOCK))
    return out.transpose(1, 0, 2, 3).reshape(bsz, seq, NSA_WIDTH)


def rwkv7_time_mix(r, k, v, w_lo, a_lo, g_lo, mu_r, mu_k, mu_v, mu_w, mu_a, mu_g,
                   w0, w_w2, a0, w_a2, w_g2, k_k, k_a, r_k, lnx_w, lnx_b):
    out_dtype = r.dtype
    bsz, seq, _ = r.shape
    H, N = RWKV_HEADS, RWKV_HEAD
    f32 = jnp.float32
    r = token_shift(r, mu_r).astype(f32)
    k = token_shift(k, mu_k).astype(f32)
    v = token_shift(v, mu_v).astype(f32)
    w_lo = token_shift(w_lo, mu_w)
    a_lo = token_shift(a_lo, mu_a)
    g_lo = token_shift(g_lo, mu_g)

    w_log = -jax.nn.softplus(-(w0 + jnp.tanh(w_lo) @ w_w2).astype(f32)) - 0.5
    decay = jnp.exp(-jnp.exp(w_log))
    a = jax.nn.sigmoid((a0 + a_lo @ w_a2).astype(f32))
    g = jax.nn.sigmoid(g_lo) @ w_g2

    kk = (k * k_k).reshape(bsz, seq, H, N)
    kk = kk / jnp.maximum(jnp.sqrt(jnp.sum(kk * kk, axis=-1, keepdims=True)), 1e-12)
    k = k * (1.0 + (a - 1.0) * k_a)

    def heads(z):
        return z.reshape(bsz, seq, H, N).transpose(1, 0, 2, 3)

    xs = (heads(r), heads(decay), heads(k), heads(v), kk.transpose(1, 0, 2, 3), heads(a))

    def step(state, inp):
        r_t, w_t, k_t, v_t, kk_t, a_t = inp
        s_kk = jnp.einsum('bhij,bhj->bhi', state, kk_t)
        state = (state * w_t[:, :, None, :] - s_kk[..., None] * (kk_t * a_t)[:, :, None, :]
                 + v_t[..., None] * k_t[:, :, None, :])
        return state, jnp.einsum('bhij,bhj->bhi', state, r_t)

    _, y = lax.scan(step, jnp.zeros((bsz, H, N, N), f32), xs)
    y = y.transpose(1, 0, 2, 3)
    mean = jnp.mean(y, axis=-1, keepdims=True)
    var = jnp.mean(jnp.square(y - mean), axis=-1, keepdims=True)
    y = ((y - mean) * lax.rsqrt(var + LNX_EPS)).reshape(bsz, seq, H * N) * lnx_w + lnx_b
    rh, kh, vh = r.reshape(bsz, seq, H, N), k.reshape(bsz, seq, H, N), v.reshape(bsz, seq, H, N)
    bonus = (jnp.sum(rh * kh * r_k, axis=-1, keepdims=True) * vh).reshape(bsz, seq, H * N)
    return ((y + bonus) * g).astype(out_dtype)


def hybrid_layer(x, norm1_pre, norm1_post, w_in,
                 cmp_pe_k, cmp_w1_k, cmp_b1_k, cmp_w2_k, cmp_pe_v, cmp_w1_v, cmp_b1_v, cmp_w2_v,
                 mu_r, mu_k, mu_v, mu_w, mu_a, mu_g, w0, w_w2, a0, w_a2, w_g2,
                 k_k, k_a, r_k, lnx_w, lnx_b, w_branch_a, w_branch_b, w_out,
                 norm2_pre, norm2_post, w_gate, w_up, w_down):
    bsz, seq, _ = x.shape
    h = rms_norm(x, norm1_pre)
    z = h @ w_in
    (q, kc, vc, ks, vs, kw, vw, nsa_g, r, k, v, w_lo, a_lo, g_lo, merge_g) = jnp.split(
        z, _split_points(), axis=-1)

    def kvh(t):
        return t.reshape(bsz, seq, NSA_KV_GROUPS, HEAD_DIM)

    o_a = nsa_attention(q.reshape(bsz, seq, NSA_HEADS, HEAD_DIM), kvh(kc), kvh(vc), kvh(ks), kvh(vs),
                        kvh(kw), kvh(vw), nsa_g,
                        cmp_pe_k, cmp_w1_k, cmp_b1_k, cmp_w2_k, cmp_pe_v, cmp_w1_v, cmp_b1_v, cmp_w2_v)
    o_b = rwkv7_time_mix(r, k, v, w_lo, a_lo, g_lo, mu_r, mu_k, mu_v, mu_w, mu_a, mu_g,
                         w0, w_w2, a0, w_a2, w_g2, k_k, k_a, r_k, lnx_w, lnx_b)

    gate_a, gate_b = jnp.split(jax.nn.sigmoid(merge_g), 2, axis=-1)
    mixed = (gate_a * (o_a @ w_branch_a) + gate_b * (o_b @ w_branch_b)) @ w_out
    x = x + rms_norm(mixed, norm1_post)

    h2 = rms_norm(x, norm2_pre)
    f = (jax.nn.silu(h2 @ w_gate) * (h2 @ w_up)) @ w_down
    return x + rms_norm(f, norm2_post)


def setup_inputs(seed: int = 0) -> dict:
    key = jax.random.key(seed)
    ks = iter(jax.random.split(key, 40))
    f32 = jnp.float32

    def nrm(shape, scale):
        return scale * jax.random.normal(next(ks), shape, f32)

    def unif(shape, lo, hi):
        return jax.random.uniform(next(ks), shape, f32, lo, hi)

    L = DEPTH
    return {
        'x': jax.random.normal(next(ks), (BATCH, SEQ, D_MODEL), f32),
        'norm1_pre': 1.0 + nrm((L, D_MODEL), 0.05),
        'norm1_post': 1.0 + nrm((L, D_MODEL), 0.05),
        'w_in': nrm((L, D_MODEL, IN_COLS), D_MODEL ** -0.5),
        'cmp_pe_k': nrm((L, CMP_LEN, HEAD_DIM), 0.1),
        'cmp_w1_k': nrm((L, CMP_LEN * HEAD_DIM, CMP_HIDDEN), (CMP_LEN * HEAD_DIM) ** -0.5),
        'cmp_b1_k': nrm((L, CMP_HIDDEN), 0.01),
        'cmp_w2_k': nrm((L, CMP_HIDDEN, HEAD_DIM), 2.0 * CMP_HIDDEN ** -0.5),
        'cmp_pe_v': nrm((L, CMP_LEN, HEAD_DIM), 0.1),
        'cmp_w1_v': nrm((L, CMP_LEN * HEAD_DIM, CMP_HIDDEN), (CMP_LEN * HEAD_DIM) ** -0.5),
        'cmp_b1_v': nrm((L, CMP_HIDDEN), 0.01),
        'cmp_w2_v': nrm((L, CMP_HIDDEN, HEAD_DIM), 2.0 * CMP_HIDDEN ** -0.5),
        'mu_r': unif((L, RWKV_WIDTH), 0.0, 1.0),
        'mu_k': unif((L, RWKV_WIDTH), 0.0, 1.0),
        'mu_v': unif((L, RWKV_WIDTH), 0.0, 1.0),
        'mu_w': unif((L, DECAY_LORA), 0.0, 1.0),
        'mu_a': unif((L, AAA_LORA), 0.0, 1.0),
        'mu_g': unif((L, GATE_LORA), 0.0, 1.0),
        'w0': unif((L, RWKV_WIDTH), -3.0, 0.5),
        'w_w2': nrm((L, DECAY_LORA, RWKV_WIDTH), 0.1),
        'a0': nrm((L, RWKV_WIDTH), 0.1),
        'w_a2': nrm((L, AAA_LORA, RWKV_WIDTH), 0.1),
        'w_g2': nrm((L, GATE_LORA, RWKV_WIDTH), GATE_LORA ** -0.5),
        'k_k': 0.85 + nrm((L, RWKV_WIDTH), 0.02),
        'k_a': 1.0 + nrm((L, RWKV_WIDTH), 0.02),
        'r_k': nrm((L, RWKV_HEADS, RWKV_HEAD), 0.1),
        'lnx_w': 1.0 + nrm((L, RWKV_WIDTH), 0.05),
        'lnx_b': nrm((L, RWKV_WIDTH), 0.01),
        'w_branch_a': nrm((L, NSA_WIDTH, D_MODEL), NSA_WIDTH ** -0.5),
        'w_branch_b': nrm((L, RWKV_WIDTH, D_MODEL), RWKV_WIDTH ** -0.5),
        'w_out': nrm((L, D_MODEL, D_MODEL), D_MODEL ** -0.5),
        'norm2_pre': 1.0 + nrm((L, D_MODEL), 0.05),
        'norm2_post': 1.0 + nrm((L, D_MODEL), 0.05),
        'w_gate': nrm((L, D_MODEL, D_FF), D_MODEL ** -0.5),
        'w_up': nrm((L, D_MODEL, D_FF), D_MODEL ** -0.5),
        'w_down': nrm((L, D_FF, D_MODEL), D_FF ** -0.5),
    }


def reference(x, norm1_pre, norm1_post, w_in,
              cmp_pe_k, cmp_w1_k, cmp_b1_k, cmp_w2_k, cmp_pe_v, cmp_w1_v, cmp_b1_v, cmp_w2_v,
              mu_r, mu_k, mu_v, mu_w, mu_a, mu_g, w0, w_w2, a0, w_a2, w_g2,
              k_k, k_a, r_k, lnx_w, lnx_b, w_branch_a, w_branch_b, w_out,
              norm2_pre, norm2_post, w_gate, w_up, w_down):
    layer_params = (norm1_pre, norm1_post, w_in,
                    cmp_pe_k, cmp_w1_k, cmp_b1_k, cmp_w2_k, cmp_pe_v, cmp_w1_v, cmp_b1_v, cmp_w2_v,
                    mu_r, mu_k, mu_v, mu_w, mu_a, mu_g, w0, w_w2, a0, w_a2, w_g2,
                    k_k, k_a, r_k, lnx_w, lnx_b, w_branch_a, w_branch_b, w_out,
                    norm2_pre, norm2_post, w_gate, w_up, w_down)
    for layer in range(DEPTH):
        x = hybrid_layer(x, *[p[layer] for p in layer_params])
    return x
```

```cpp
#include <hip/hip_runtime.h>
#include <cstdio>
#include <cstdint>

#define LAS __attribute__((address_space(3)))
#define GAS __attribute__((address_space(1)))
typedef unsigned short bf16_t;
typedef short bf16x8 __attribute__((ext_vector_type(8)));
typedef short bf16x4 __attribute__((ext_vector_type(4)));
typedef float f32x4 __attribute__((ext_vector_type(4)));
typedef float f32x2 __attribute__((ext_vector_type(2)));
typedef unsigned u32x4 __attribute__((ext_vector_type(4)));
typedef unsigned u32x2 __attribute__((ext_vector_type(2)));
typedef __bf16 bf16x2_t __attribute__((ext_vector_type(2)));

constexpr int BATCH = 4, SEQ = 8192, DM = 1024, NTOK = BATCH * SEQ;
constexpr int DFF = 2816;
constexpr int ZP = 2560;
constexpr int C_Q = 0, C_KC = 512, C_VC = 640, C_R = 768, C_K = 1280, C_V = 1792,
              C_WLO = 2304, C_ALO = 2336, C_GLO = 2368, C_NG = 2464;
constexpr float QSCALE = 0.125f * 1.4426950408889634f;
constexpr float LOG2E = 1.4426950408889634f;

__device__ __forceinline__ unsigned cvtpk(float lo, float hi) { f32x2 v = {lo, hi}; bf16x2_t b = __builtin_convertvector(v, bf16x2_t); return __builtin_bit_cast(unsigned, b); }
__device__ __forceinline__ bf16_t f2bf(float f) { return (bf16_t)(cvtpk(f, 0.f) & 0xffffu); }
__device__ __forceinline__ float bf2f(bf16_t h) { return __builtin_bit_cast(float, ((unsigned)h) << 16); }
__device__ __forceinline__ float bflo(unsigned w) { return __builtin_bit_cast(float, w << 16); }
__device__ __forceinline__ float bfhi(unsigned w) { return __builtin_bit_cast(float, w & 0xffff0000u); }
__device__ __forceinline__ float fast_exp2(float x) { return __builtin_amdgcn_exp2f(x); }
__device__ __forceinline__ float frcp(float x) { return __builtin_amdgcn_rcpf(x); }
__device__ __forceinline__ float sigmoidf_(float x) { return frcp(1.0f + __expf(-x)); }

namespace pg8 {
constexpr int BM = 256, BK = 64, HALF = 128, HTB = HALF * BK * 2, STAGE_BYTES = 8 * HTB, NXCD = 8, WGM = 8;
__host__ __device__ __forceinline__ int lds_byte(int r, int c) { const int st = (r >> 4) * 2 + (c >> 5), rr = r & 15, cc = c & 31, ob = rr * 64 + cc * 2; return st * 1024 + (ob ^ (((ob >> 9) & 1) << 5)); }
__host__ __device__ __forceinline__ void stage_rc(int b, int& R, int& C) { const int st = b / 1024, sb = b % 1024, swz = sb ^ (((sb >> 9) & 1) << 5); R = (st >> 1) * 16 + swz / 64; C = (st & 1) * 32 + (swz % 64) / 2; }
__host__ __device__ __forceinline__ int perm32(int rho) { const int n = rho >> 4, i = rho & 15; return 8 * (i >> 2) + 4 * n + (i & 3); }

struct Unit { int pm, pn; const char* a; const char* b; int part; };
struct Gemm { int K; int lda; unsigned kstepA; int unused_; };

struct StaticOrder {
    int nM, nN, nwg, G, c; const char* A; const char* Bt; size_t tstepA, tstepB;
    __device__ void init(const void* A_, const void* Bt_, int M, int N, int K, int lda, int G_, int c_) { nM = M / BM; nN = N / BM; nwg = nM * nN; G = G_; c = c_; A = (const char*)A_; Bt = (const char*)Bt_; tstepA = (size_t)BM * lda * 2; tstepB = (size_t)BM * K * 2; }
    __device__ bool next(int i, Unit& u) const {
        const long L = (long)i * G + c; if (L >= nwg) return false;
        int wgid = (int)L; { const int q = nwg / NXCD, r = nwg % NXCD, xcd = wgid % NXCD, off = wgid / NXCD; wgid = (xcd < r ? xcd * (q + 1) : r * (q + 1) + (xcd - r) * q) + off; }
        const int nig = WGM * nN, gid = wgid / nig, fm = gid * WGM, gsz = (nM - fm) < WGM ? (nM - fm) : WGM;
        u.pm = fm + ((wgid % nig) % gsz); u.pn = (wgid % nig) / gsz; u.a = A + (size_t)u.pm * tstepA; u.b = Bt + (size_t)u.pn * tstepB; u.part = 1; return true;
    }
};
struct TwoPartOrder {
    StaticOrder S; size_t a2off, b2off;
    __device__ bool next(int i, Unit& u) const { if (!S.next(i >> 1, u)) return false; u.part = i & 1; if (i & 1) { u.a += a2off; u.b += b2off; } return true; }
};

template <class Epi, class Sched>
__device__ __forceinline__ void gemm_phase(LAS unsigned char* lds, const Gemm g, const Sched& S, const Epi& E) {
    int tid_ = threadIdx.x; asm volatile("" : "+v"(tid_));
    const int tid = tid_, wid = __builtin_amdgcn_readfirstlane(tid >> 6), lane = tid & 63, wr = wid >> 2, wc = wid & 3, fr = lane & 15, fq = lane >> 4;
    const int K = g.K, nt = K / BK;
    unsigned voffA[2], voffB[2];
#pragma unroll
    for (int i = 0; i < 2; ++i) { int R, C; stage_rc(tid * 16 + i * 8192, R, C); const int Rb = Epi::PERM ? ((R & ~31) + perm32(R & 31)) : R;
        voffA[i] = (unsigned)(R * g.lda + C) * 2u; voffB[i] = (unsigned)(Rb * K + C) * 2u; }
    const size_t kstepA = (size_t)g.kstepA, kstepB = (size_t)(BK * 2);
    const size_t hstepA = (size_t)HALF * g.lda * 2, hstepB = (size_t)HALF * K * 2;
    const unsigned ldsw = (unsigned)wid * 1024u;
    const int aoff = lds_byte(wr * 64 + fr, fq * 8), boff = lds_byte(wc * 32 + fr, fq * 8);
#define PG8_SA(b, h) (((b) * 2 + (h)) * HTB)
#define PG8_SB(b, h) ((4 + (b) * 2 + (h)) * HTB)
#define PG8_STAGE(bufoff, gbase, voff) do { _Pragma("unroll") for (int _i = 0; _i < 2; ++_i) \
        __builtin_amdgcn_global_load_lds((const unsigned*)((const char*)(gbase) + (voff)[_i]), (LAS unsigned*)(lds + (bufoff) + ldsw + _i * 8192), 16, 0, 0); } while (0)
#define PG8_LDA(dst, b, h) do { _Pragma("unroll") for (int m = 0; m < 4; ++m) _Pragma("unroll") for (int k = 0; k < 2; ++k) dst[m][k] = *(const LAS bf16x8*)(lds + PG8_SA(b, h) + aoff + m * 2048 + k * 1024); } while (0)
#define PG8_LDB(dst, b, h) do { _Pragma("unroll") for (int n = 0; n < 2; ++n) _Pragma("unroll") for (int k = 0; k < 2; ++k) dst[n][k] = *(const LAS bf16x8*)(lds + PG8_SB(b, h) + boff + n * 2048 + k * 1024); } while (0)
#define PG8_MMA(ai, bj, At, Bt) do { __builtin_amdgcn_s_setprio(1); _Pragma("unroll") for (int m = 0; m < 4; ++m) _Pragma("unroll") for (int n = 0; n < 2; ++n) _Pragma("unroll") for (int k = 0; k < 2; ++k) \
        acc[ai][bj][m][n] = __builtin_amdgcn_mfma_f32_16x16x32_bf16(Bt[n][k], At[m][k], acc[ai][bj][m][n], 0, 0, 0); __builtin_amdgcn_s_setprio(0); } while (0)
#define PG8_WAIT_V(n) asm volatile("s_waitcnt vmcnt(" #n ")" ::: "memory")
#define PG8_WAIT_L(n) asm volatile("s_waitcnt lgkmcnt(" #n ")" ::: "memory")
#define PG8_BAR __builtin_amdgcn_s_barrier()
#define PG8_SCHED __builtin_amdgcn_sched_barrier(0)
    Unit cur, nxt; int ui = 0;
    if (!S.next(0, cur)) return;
    f32x4 acc[2][2][4][2];
#pragma unroll
    for (int a = 0; a < 2; ++a)
#pragma unroll
        for (int b = 0; b < 2; ++b)
#pragma unroll
            for (int m = 0; m < 4; ++m)
#pragma unroll
                for (int n = 0; n < 2; ++n) acc[a][b][m][n] = (f32x4){0.f, 0.f, 0.f, 0.f};
    bf16x8 At[4][2], B0[2][2], B1[2][2];
    const char* cA = cur.a; const char* cB = cur.b;
    PG8_STAGE(PG8_SB(0, 0), cB, voffB); PG8_STAGE(PG8_SB(0, 1), cB + hstepB, voffB); PG8_STAGE(PG8_SA(0, 0), cA, voffA); PG8_STAGE(PG8_SA(0, 1), cA + hstepA, voffA);
    if (wr == 1) PG8_BAR;
    PG8_WAIT_V(2); PG8_BAR;
    PG8_STAGE(PG8_SB(1, 0), cB + kstepB, voffB); PG8_STAGE(PG8_SA(1, 0), cA + kstepA, voffA); PG8_STAGE(PG8_SB(1, 1), cB + hstepB + kstepB, voffB);
    PG8_WAIT_V(6); PG8_BAR;
    for (;;) {
        const bool has_next = S.next(ui + 1, nxt);
        const char* nA = has_next ? nxt.a : cA; const char* nB = has_next ? nxt.b : cB;
        for (int t = 0; t < nt; t += 2) {
            const bool last = (t == nt - 2);
            const char* a1 = cA + (size_t)(t + 1) * kstepA;
            const char* a2 = last ? nA : cA + (size_t)(t + 2) * kstepA; const char* b2 = last ? nB : cB + (size_t)(t + 2) * kstepB;
            const char* a3 = a2 + kstepA; const char* b3 = b2 + kstepB;
            PG8_LDB(B0, 0, 0); PG8_LDB(B1, 0, 1); PG8_SCHED; PG8_LDA(At, 0, 0); PG8_STAGE(PG8_SA(1, 1), a1 + hstepA, voffA);
            PG8_WAIT_V(8); PG8_WAIT_L(0); PG8_BAR; PG8_MMA(0, 0, At, B0); PG8_MMA(0, 1, At, B1); PG8_BAR; PG8_SCHED;
            PG8_LDA(At, 0, 1); PG8_STAGE(PG8_SB(0, 0), b2, voffB); PG8_STAGE(PG8_SB(0, 1), b2 + hstepB, voffB); PG8_STAGE(PG8_SA(0, 0), a2, voffA);
            PG8_WAIT_V(8); PG8_WAIT_L(0); PG8_BAR; PG8_MMA(1, 0, At, B0); PG8_MMA(1, 1, At, B1); PG8_BAR; PG8_SCHED;
            PG8_LDB(B0, 1, 0); PG8_LDB(B1, 1, 1); PG8_SCHED; PG8_LDA(At, 1, 0); PG8_STAGE(PG8_SA(0, 1), a2 + hstepA, voffA);
            PG8_WAIT_V(8); PG8_WAIT_L(0); PG8_BAR; PG8_MMA(0, 0, At, B0); PG8_MMA(0, 1, At, B1); PG8_BAR; PG8_SCHED;
            PG8_LDA(At, 1, 1); PG8_STAGE(PG8_SB(1, 0), b3, voffB); PG8_STAGE(PG8_SB(1, 1), b3 + hstepB, voffB); PG8_STAGE(PG8_SA(1, 0), a3, voffA);
            PG8_WAIT_V(8); PG8_WAIT_L(0); PG8_BAR; PG8_MMA(1, 0, At, B0); PG8_MMA(1, 1, At, B1); PG8_BAR; PG8_SCHED;
        }
        if (wr == 0) PG8_BAR;
        const bool midpart = Epi::TWO_PART && (cur.part == 0);
        if (midpart) E.mid(acc, cur, wr, wc, fr, fq); else E(acc, cur, wr, wc, fr, fq);
        if (!has_next) break;
        if (!midpart) {
#pragma unroll
        for (int a = 0; a < 2; ++a)
#pragma unroll
            for (int b = 0; b < 2; ++b)
#pragma unroll
                for (int m = 0; m < 4; ++m)
#pragma unroll
                    for (int n = 0; n < 2; ++n) acc[a][b][m][n] = (f32x4){0.f, 0.f, 0.f, 0.f};
        }
        cur = nxt; cA = nA; cB = nB; ++ui;
        if (wr == 1) PG8_BAR;
    }
    PG8_WAIT_V(0);
    PG8_BAR;
#undef PG8_SA
#undef PG8_SB
#undef PG8_STAGE
#undef PG8_LDA
#undef PG8_LDB
#undef PG8_MMA
#undef PG8_WAIT_V
#undef PG8_WAIT_L
#undef PG8_BAR
#undef PG8_SCHED
}
}

typedef f32x4 AccT[2][2][4][2];

__device__ __forceinline__ int vt_keypos(int t) { const int u = (t >> 2) & 15; return (t & ~63) | ((((u & 8) | ((u & 3) << 1) | ((u >> 2) & 1))) << 2) | (t & 3); }
struct EpiZ {
    static constexpr bool PERM = true, TWO_PART = false;
    __device__ __forceinline__ void mid(AccT& acc, const pg8::Unit& u, int wr, int wc, int fr, int fq) const {}
    bf16_t* ZA; bf16_t* MG; bf16_t* QR; bf16_t* VST; bf16_t* VWT; bf16_t* KSB; bf16_t* KWB; const float* rope;
    __device__ __forceinline__ void operator()(const AccT& acc, const pg8::Unit& u, int wr, int wc, int fr, int fq) const {
        const int pn = u.pn, row0 = u.pm * 256 + wr * 64 + fr, cin = wc * 32 + 8 * fq, c8 = 4 * (wc & 1) + fq;
#pragma unroll
        for (int ai = 0; ai < 2; ++ai)
#pragma unroll
            for (int m = 0; m < 4; ++m) {
                const int row = row0 + ai * 128 + m * 16, t = row & (SEQ - 1);
#pragma unroll
                for (int bj = 0; bj < 2; ++bj) {
                    f32x4 v0 = acc[ai][bj][m][0], v1 = acc[ai][bj][m][1];
                    const int c = pn * 256 + bj * 128 + cin;
                    const bool isq = pn < 2, iskv = (pn == 3 || pn == 4);
                    if (isq || (iskv && bj == 0)) {
                        if (isq) { v0 = v0 * QSCALE; v1 = v1 * QSCALE; u32x4 w; w.x = cvtpk(v0[0], v0[1]); w.y = cvtpk(v0[2], v0[3]); w.z = cvtpk(v1[0], v1[1]); w.w = cvtpk(v1[2], v1[3]);
                            *(u32x4*)(ZA + (size_t)row * ZP + c) = w; }
                        const float* rp = rope + ((size_t)t * 32 + 4 * c8) * 2; const f32x4 r0 = *(const f32x4*)rp, r1 = *(const f32x4*)(rp + 4);
                        f32x4 o1, o2;
                        o1[0] = v0[0] * r0[0] - v1[0] * r0[1]; o2[0] = v0[0] * r0[1] + v1[0] * r0[0];
                        o1[1] = v0[1] * r0[2] - v1[1] * r0[3]; o2[1] = v0[1] * r0[3] + v1[1] * r0[2];
                        o1[2] = v0[2] * r1[0] - v1[2] * r1[1]; o2[2] = v0[2] * r1[1] + v1[2] * r1[0];
                        o1[3] = v0[3] * r1[2] - v1[3] * r1[3]; o2[3] = v0[3] * r1[3] + v1[3] * r1[2];
                        u32x4 w; w.x = cvtpk(o1[0], o1[1]); w.y = cvtpk(o1[2], o1[3]); w.z = cvtpk(o2[0], o2[1]); w.w = cvtpk(o2[2], o2[3]);
                        if (isq) *(u32x4*)(QR + (size_t)row * 512 + c) = w;
                        else { bf16_t* KB = (pn == 3) ? KSB : KWB; *(u32x4*)(KB + (((size_t)((row >> 13) * 2 + (wc >> 1)) * SEQ + t) * 64 + 32 * (wc & 1) + 8 * fq)) = w; }
                    } else if (iskv) {
                        bf16_t* VT = (pn == 3) ? VST : VWT; const int gg = wc >> 1, d0 = 32 * (wc & 1) + 8 * fq, b = row >> 13;
                        bf16_t* base = VT + ((((size_t)(b * 2 + gg) * 128 + (t >> 6)) * 64 + d0) * 64) + (vt_keypos(t) & 63);
#pragma unroll
                        for (int e = 0; e < 4; ++e) { base[e * 64] = f2bf(v0[e]); base[(4 + e) * 64] = f2bf(v1[e]); }
                    } else {
                        u32x4 w; w.x = cvtpk(v0[0], v0[1]); w.y = cvtpk(v0[2], v0[3]); w.z = cvtpk(v1[0], v1[1]); w.w = cvtpk(v1[2], v1[3]);
                        if (pn < 12) *(u32x4*)(ZA + (size_t)row * ZP + ((pn >= 5) ? c - 512 : c)) = w; else *(u32x4*)(MG + (size_t)row * 2048 + (c - 3072)) = w;
                    }
                }
            }
    }
};
__device__ __forceinline__ float gelu_tanh(float x) { const float u = 0.7978845608028654f * (x + 0.044715f * x * x * x); const float e = fast_exp2(u * (2.0f * LOG2E)); const float th = 1.0f - 2.0f * frcp(e + 1.0f); return 0.5f * x * (1.0f + th); }
struct EpiCmp {
    static constexpr bool PERM = true, TWO_PART = false;
    __device__ __forceinline__ void mid(AccT& acc, const pg8::Unit& u, int wr, int wc, int fr, int fq) const {}
    bf16_t* H; const float* b1p;
    __device__ __forceinline__ void operator()(const AccT& acc, const pg8::Unit& u, int wr, int wc, int fr, int fq) const {
        const int kv = u.pm >> 4, rt = u.pm & 15; const int row0 = rt * 256 + wr * 64 + fr;
#pragma unroll
        for (int bj = 0; bj < 2; ++bj) { const int c = bj * 128 + wc * 32 + 8 * fq; const f32x4 ba = *(const f32x4*)(b1p + kv * 256 + c), bb = *(const f32x4*)(b1p + kv * 256 + c + 4);
#pragma unroll
            for (int ai = 0; ai < 2; ++ai)
#pragma unroll
                for (int m = 0; m < 4; ++m) { const int row = row0 + ai * 128 + m * 16; const f32x4 v0 = acc[ai][bj][m][0] + ba, v1 = acc[ai][bj][m][1] + bb;
                    u32x4 w; w.x = cvtpk(gelu_tanh(v0[0]), gelu_tanh(v0[1])); w.y = cvtpk(gelu_tanh(v0[2]), gelu_tanh(v0[3])); w.z = cvtpk(gelu_tanh(v1[0]), gelu_tanh(v1[1])); w.w = cvtpk(gelu_tanh(v1[2]), gelu_tanh(v1[3]));
                    *(u32x4*)(H + ((size_t)kv * 4096 + row) * 256 + c) = w; } }
    }
};
struct EpiMerge {
    static constexpr bool PERM = true, TWO_PART = true;
    const bf16_t* MG; bf16_t* MIXP;
    static __device__ __forceinline__ void ratio4(f32x4& r, unsigned a0, unsigned a1, unsigned b0, unsigned b1) {
        r[0] = (1.f + __expf(-bflo(b0))) * frcp(1.f + __expf(-bflo(a0))); r[1] = (1.f + __expf(-bfhi(b0))) * frcp(1.f + __expf(-bfhi(a0)));
        r[2] = (1.f + __expf(-bflo(b1))) * frcp(1.f + __expf(-bflo(a1))); r[3] = (1.f + __expf(-bfhi(b1))) * frcp(1.f + __expf(-bfhi(a1))); }
    __device__ __forceinline__ void mid(AccT& acc, const pg8::Unit& u, int wr, int wc, int fr, int fq) const {
        const unsigned off0 = (unsigned)(u.pm * 256 + wr * 64 + fr) * 4096u + (unsigned)(u.pn * 256 + wc * 32 + 8 * fq) * 2u;
        const char* mg = (const char*)MG;
        u32x4 ga[2][2], gb[2][2];
#define EM_LOAD(BUF, GRP) do { _Pragma("unroll") for (int bj = 0; bj < 2; ++bj) { const unsigned off = off0 + (unsigned)((((GRP) >> 2) * 128 + ((GRP) & 3) * 16)) * 4096u + (unsigned)(bj * 256); \
            ga[BUF][bj] = *(const u32x4*)(mg + off); gb[BUF][bj] = *(const u32x4*)(mg + off + 2048u); } } while (0)
        EM_LOAD(0, 0);
#pragma unroll
        for (int grp = 0; grp < 8; ++grp) { const int ai = grp >> 2, m = grp & 3, cb = grp & 1;
            if (grp + 1 < 8) EM_LOAD((grp + 1) & 1, grp + 1);
#pragma unroll
            for (int bj = 0; bj < 2; ++bj) { f32x4 r0, r1; ratio4(r0, ga[cb][bj].x, ga[cb][bj].y, gb[cb][bj].x, gb[cb][bj].y); ratio4(r1, ga[cb][bj].z, ga[cb][bj].w, gb[cb][bj].z, gb[cb][bj].w);
                acc[ai][bj][m][0] = acc[ai][bj][m][0] * r0; acc[ai][bj][m][1] = acc[ai][bj][m][1] * r1; }
            asm volatile("" ::: "memory"); }
#undef EM_LOAD
    }
    __device__ __forceinline__ void operator()(const AccT& acc, const pg8::Unit& u, int wr, int wc, int fr, int fq) const {
        const int row0 = u.pm * 256 + wr * 64 + fr, c0 = u.pn * 256 + wc * 32 + 8 * fq;
#pragma unroll
        for (int ai = 0; ai < 2; ++ai)
#pragma unroll
            for (int m = 0; m < 4; ++m) { const int row = row0 + ai * 128 + m * 16;
#pragma unroll
                for (int bj = 0; bj < 2; ++bj) { const int c = c0 + bj * 128; const u32x4 gw = *(const u32x4*)(MG + (size_t)row * 2048 + 1024 + c); const f32x4 a = acc[ai][bj][m][0], b2 = acc[ai][bj][m][1];
                    u32x4 w; w.x = cvtpk(a[0] * sigmoidf_(bflo(gw.x)), a[1] * sigmoidf_(bfhi(gw.x))); w.y = cvtpk(a[2] * sigmoidf_(bflo(gw.y)), a[3] * sigmoidf_(bfhi(gw.y)));
                    w.z = cvtpk(b2[0] * sigmoidf_(bflo(gw.z)), b2[1] * sigmoidf_(bfhi(gw.z))); w.w = cvtpk(b2[2] * sigmoidf_(bflo(gw.w)), b2[3] * sigmoidf_(bfhi(gw.w)));
                    *(u32x4*)(MIXP + (size_t)row * 1024 + c) = w; } }
    }
};
struct EpiBf16Plain {
    static constexpr bool PERM = true, TWO_PART = false;
    bf16_t* O; int ldc;
    __device__ __forceinline__ void mid(AccT& acc, const pg8::Unit& u, int wr, int wc, int fr, int fq) const {}
    __device__ __forceinline__ void operator()(const AccT& acc, const pg8::Unit& u, int wr, int wc, int fr, int fq) const {
        const int row0 = u.pm * 256 + wr * 64 + fr, c0 = u.pn * 256 + wc * 32 + 8 * fq;
#pragma unroll
        for (int ai = 0; ai < 2; ++ai)
#pragma unroll
            for (int m = 0; m < 4; ++m) { const int row = row0 + ai * 128 + m * 16;
#pragma unroll
                for (int bj = 0; bj < 2; ++bj) { const f32x4 v0 = acc[ai][bj][m][0], v1 = acc[ai][bj][m][1];
                    u32x4 w; w.x = cvtpk(v0[0], v0[1]); w.y = cvtpk(v0[2], v0[3]); w.z = cvtpk(v1[0], v1[1]); w.w = cvtpk(v1[2], v1[3]);
                    *(u32x4*)(O + (size_t)row * ldc + c0 + bj * 128) = w; } }
    }
};
struct EpiSwiGLU {
    static constexpr bool PERM = true, TWO_PART = false;
    __device__ __forceinline__ void mid(AccT& acc, const pg8::Unit& u, int wr, int wc, int fr, int fq) const {}
    bf16_t* ACT;
    __device__ __forceinline__ void operator()(const AccT& acc, const pg8::Unit& u, int wr, int wc, int fr, int fq) const {
        const int row0 = u.pm * 256 + wr * 64 + fr, c = u.pn * 128 + wc * 32 + 8 * fq;
#pragma unroll
        for (int ai = 0; ai < 2; ++ai)
#pragma unroll
            for (int m = 0; m < 4; ++m) { const int row = row0 + ai * 128 + m * 16; float o[8];
#pragma unroll
                for (int n = 0; n < 2; ++n)
#pragma unroll
                    for (int e = 0; e < 4; ++e) { const float gt = acc[ai][0][m][n][e], up = acc[ai][1][m][n][e]; o[n * 4 + e] = gt * sigmoidf_(gt) * up; }
                u32x4 w; w.x = cvtpk(o[0], o[1]); w.y = cvtpk(o[2], o[3]); w.z = cvtpk(o[4], o[5]); w.w = cvtpk(o[6], o[7]);
                *(u32x4*)(ACT + (size_t)row * DFF + c) = w; }
    }
};
struct CmpOrder {
    int c; const bf16_t* ZA; const bf16_t* W1kT; const bf16_t* W1vT;
    __device__ bool next(int i, pg8::Unit& u) const {
        if (i > 0 || c >= 32) return false;
        u.pm = c; u.pn = 0; const int kv = c >> 4, bg = (c >> 1) & 7, nt2 = c & 1, b = bg >> 1, gg = bg & 1;
        u.a = (const char*)(ZA + ((size_t)(b * SEQ + 16 * 256 * nt2)) * ZP + C_KC + kv * 128 + gg * 64);
        u.b = (const char*)(kv ? W1vT : W1kT); u.part = 1; return true;
    }
};

constexpr size_t MiB = 1u << 20;
constexpr size_t WS_CTL = 0, CTL_ZERO_BYTES = 64 * 1024;
constexpr size_t WS_WIN = 1 * MiB;
constexpr size_t WS_WA = 11 * MiB;
constexpr size_t WS_WB = 12 * MiB;
constexpr size_t WS_WOUT = 13 * MiB;
constexpr size_t WS_WGU = 15 * MiB;
constexpr size_t WS_WD = 26 * MiB;
constexpr size_t WS_W1K = 32 * MiB;
constexpr size_t WS_W1V = 33 * MiB;
constexpr size_t WS_ROPE = 34 * MiB;
constexpr size_t WS_B1P = 36 * MiB;
constexpr size_t WS_W2W = 36 * MiB + 65536;
constexpr size_t WS_W2A = WS_W2W + 32768, WS_WGT = WS_W2A + 32768;
constexpr size_t WS_BON = 37 * MiB;
constexpr size_t WS_XN = 40 * MiB;
constexpr size_t WS_ZA = 104 * MiB;
constexpr size_t WS_KSB = 264 * MiB, WS_KWB = 272 * MiB;
constexpr size_t WS_MG = 296 * MiB;
constexpr size_t WS_QR = 424 * MiB;
constexpr size_t WS_VST = 456 * MiB;
constexpr size_t WS_VWT = 464 * MiB;
constexpr size_t WS_KC = 472 * MiB;
constexpr size_t WS_VCT = 473 * MiB;
constexpr size_t WS_HID = 474 * MiB;
constexpr size_t WS_AA = 478 * MiB;
constexpr size_t WS_END = 512 * MiB;
constexpr int CW_BAR = 1024;
constexpr int CW_Q_POST = 768, CW_SCAN_DONE = 832;
constexpr int CW_Q_CHUNK = 5120, CW_Q_NSA = 128;

constexpr int RING_BYTES = 131072, LDSCTL_OFF = RING_BYTES, MISC_OFF = LDSCTL_OFF + 320, LDS_BYTES = 147456, NWAVES = 8;

typedef GAS unsigned gu32;
#define RLX_AGENT __ATOMIC_RELAXED, __HIP_MEMORY_SCOPE_AGENT
#define LDS_WAIT() asm volatile("s_waitcnt lgkmcnt(0)" ::: "memory")
#define VM_WAIT() asm volatile("s_waitcnt vmcnt(0)" ::: "memory")

#define XB_TMO      128
#define XB_XCNT(j)  (256  + 64 * (j))
#define XB_XSUB(j)  (1280 + 64 * (j))
#define XB_XGEN(j)  (2304 + 64 * (j))
#define XB_TOP      3328
#define XB_TOPGEN   3392
#define XCD_BAR_WORDS 3456
#define XB_SPIN_CAP (1u << 22)
__device__ __forceinline__ unsigned xb_ld(unsigned* p)              { return __hip_atomic_load(p, __ATOMIC_RELAXED, __HIP_MEMORY_SCOPE_AGENT); }
__device__ __forceinline__ unsigned xb_add(unsigned* p, unsigned v) { return __hip_atomic_fetch_add(p, v, __ATOMIC_RELAXED, __HIP_MEMORY_SCOPE_AGENT); }
__device__ __forceinline__ unsigned xb_xcc_id() { return (unsigned)__builtin_amdgcn_s_getreg((3 << 11) | 20) & 0xFu; }
#define XB_SPIN(cond, bar) do { unsigned _sp = 0; while (cond) { __builtin_amdgcn_s_sleep(1); \
    if ((++_sp & 255u) == 0u) { if (xb_ld(&(bar)[XB_TMO])) break; if (_sp > XB_SPIN_CAP) { atomicAdd(&(bar)[XB_TMO], 1u); break; } } } } while (0)
struct XcdBarrier { unsigned* bar; unsigned x; volatile LAS unsigned* st; };
__device__ __forceinline__ XcdBarrier xcd_barrier_post(unsigned* bar, volatile LAS unsigned* st) {
    XcdBarrier b; b.bar = bar; b.x = xb_xcc_id(); b.st = st;
    if (threadIdx.x == 0) (void)xb_add(&bar[XB_XCNT(b.x)], 1u);
    return b;
}
__device__ __forceinline__ void xcd_barrier_complete(unsigned* bar, unsigned x, unsigned& nloc, unsigned& nx) {
    const unsigned G = gridDim.x * gridDim.y * gridDim.z;
    unsigned sum, cnt, mine, sp = 0u;
    for (;;) {
        sum = 0u; cnt = 0u; mine = 0u;
#pragma unroll
        for (unsigned j = 0; j < 16; ++j) { const unsigned c = xb_ld(&bar[XB_XCNT(j)]); sum += c; cnt += (c > 0u) ? 1u : 0u; mine = (j == x) ? c : mine; }
        if (sum == G) break;
        __builtin_amdgcn_s_sleep(1);
        if ((++sp & 255u) == 0u) { if (xb_ld(&bar[XB_TMO])) break; if (sp > XB_SPIN_CAP) { atomicAdd(&bar[XB_TMO], 1u); break; } }
    }
    nloc = mine > 0u ? mine : 1u; nx = cnt > 0u ? cnt : 1u;
}
__device__ __forceinline__ void xcd_barrier(const XcdBarrier& b) {
    asm volatile("s_waitcnt vmcnt(0)" ::: "memory");
    __syncthreads();
    if (threadIdx.x == 0) {
        unsigned* bar = b.bar;
        __builtin_amdgcn_s_waitcnt(0);
        unsigned nloc = b.st[0], nx = b.st[1];
        if (nloc == 0u) { xcd_barrier_complete(bar, b.x, nloc, nx); b.st[0] = nloc; b.st[1] = nx; }
        const unsigned old = xb_add(&bar[XB_XSUB(b.x)], 1u);
        const unsigned gen = old / nloc;
        if (old + 1u == (gen + 1u) * nloc) {
            __builtin_amdgcn_fence(__ATOMIC_RELEASE, "agent");
            asm volatile("s_waitcnt vmcnt(0)" ::: "memory");
            const unsigned og = xb_add(&bar[XB_TOP], 1u);
            const unsigned tg = og / nx;
            if (og + 1u == (tg + 1u) * nx) xb_add(&bar[XB_TOPGEN], 1u);
            else XB_SPIN(xb_ld(&bar[XB_TOPGEN]) == tg, bar);
            __builtin_amdgcn_fence(__ATOMIC_ACQUIRE, "agent");
            xb_add(&bar[XB_XGEN(b.x)], 1u);
            asm volatile("s_waitcnt vmcnt(0)" ::: "memory");
        } else {
            XB_SPIN(xb_ld(&bar[XB_XGEN(b.x)]) == gen, bar);
            __builtin_amdgcn_fence(__ATOMIC_ACQUIRE, "agent");
            asm volatile("s_waitcnt vmcnt(0)" ::: "memory");
        }
    }
    __syncthreads();
}

struct Args { const float* in[36]; float* out; unsigned char* ws; };
struct Frame {
    const Args& A;
    LAS unsigned char* lds; volatile LAS unsigned* MISC; unsigned* ctl;
    int tid, lane, wave, vcu, G, gw, NGW, z; GAS unsigned char* wsb;
};
#define PHASE_FRAME(F, F0) Frame F = F0; asm volatile("" : "+v"(F.tid), "+v"(F.lane), "+s"(F.wave), "+s"(F.z), "+s"(F.wsb), "+s"(F.gw), "+s"(F.vcu))
enum { I_X = 0, I_N1PRE, I_N1POST, I_WIN, I_PEK, I_W1K, I_B1K, I_W2K, I_PEV, I_W1V, I_B1V, I_W2V, I_MUR, I_MUK, I_MUV, I_MUW, I_MUA, I_MUG, I_W0, I_WW2, I_A0, I_WA2, I_WG2,
       I_KK, I_KA, I_RK, I_LNXW, I_LNXB, I_WBA, I_WBB, I_WOUT, I_N2PRE, I_N2POST, I_WGATE, I_WUP, I_WDOWN };

__device__ __forceinline__ float wave_sum(float v) {
#pragma unroll
    for (int o = 1; o < 64; o <<= 1) v += __shfl_xor(v, o);
    return v;
}
__device__ __forceinline__ float dpp_sum(float v) {
    int x = __builtin_bit_cast(int, v);
#define DPP_ADD(ctrl, rm) { const int t_ = __builtin_amdgcn_update_dpp(0, x, ctrl, rm, 0xF, false); x = __builtin_bit_cast(int, __builtin_bit_cast(float, x) + __builtin_bit_cast(float, t_)); }
    DPP_ADD(0xB1, 0xF) DPP_ADD(0x4E, 0xF) DPP_ADD(0x141, 0xF) DPP_ADD(0x140, 0xF) DPP_ADD(0x142, 0xA) DPP_ADD(0x143, 0xC)
#undef DPP_ADD
    return __builtin_bit_cast(float, __builtin_amdgcn_readlane(x, 63));
}

__device__ __forceinline__ int rope_perm64(int pp) { const int c8 = pp >> 3, e = pp & 7; return (e < 4) ? 4 * c8 + e : 32 + 4 * c8 + (e - 4); }
__device__ __forceinline__ int zcol_src(int p) {
    if (p < 512) return (p & ~63) + rope_perm64(p & 63);
    if (p < 768) return p;
    if (p < 896) return 768 + ((p - 768) & ~63) + rope_perm64((p - 768) & 63);
    if (p < 1024) return p;
    if (p < 1152) return 1024 + ((p - 1024) & ~63) + rope_perm64((p - 1024) & 63);
    if (p < 1280) return p;
    if (p < 2816) return 1304 + (p - 1280);
    if (p < 2976) return 2840 + (p - 2816);
    if (p < 3000) return 1280 + (p - 2976);
    if (p < 3072) return -1;
    return 3000 + (p - 3072);
}
template <class Src>
__device__ __forceinline__ void transpose_item(const Src& src, int ldw, bf16_t* WT, int ldk, LAS float* scr, int kb, int nb, int lane) {
    const int k0 = 64 * kb, n0 = 32 * nb, kr = lane >> 3, nq = lane & 7;
    const float* cp = src(n0 + 4 * nq);
    f32x4 v[8];
#pragma unroll
    for (int i = 0; i < 8; ++i) v[i] = cp ? *(const f32x4*)(cp + (size_t)(k0 + 8 * i + kr) * ldw) : (f32x4){0.f, 0.f, 0.f, 0.f};
#pragma unroll
    for (int i = 0; i < 8; ++i) { LAS float* d = scr + (8 * i + kr) * 33 + 4 * nq; d[0] = v[i][0]; d[1] = v[i][1]; d[2] = v[i][2]; d[3] = v[i][3]; }
    LDS_WAIT(); asm volatile("" ::: "memory");
    const int c = lane & 7;
#pragma unroll
    for (int j = 0; j < 4; ++j) { const int n = (lane >> 3) + 8 * j; const LAS float* s = scr + (8 * c) * 33 + n;
        u32x4 o; o.x = cvtpk(s[0 * 33], s[1 * 33]); o.y = cvtpk(s[2 * 33], s[3 * 33]); o.z = cvtpk(s[4 * 33], s[5 * 33]); o.w = cvtpk(s[6 * 33], s[7 * 33]);
        *(u32x4*)(WT + (size_t)(n0 + n) * ldk + k0 + 8 * c) = o; }
    LDS_WAIT(); asm volatile("" ::: "memory");
}

__device__ __forceinline__ void p0_prologue(Frame& F0) {
    PHASE_FRAME(F, F0);
    LAS float* scr = (LAS float*)(F.lds + F.wave * 16384);
    const int gw = F.gw, NGW = F.NGW, lane = F.lane;
    constexpr int I_IN = 16 * 160, I_A = 8 * 32, I_O = 16 * 32, I_GU = 16 * 176, I_D = 44 * 32, I_1 = 32 * 8;
    constexpr int NITEMS = I_IN + 2 * I_A + I_O + I_GU + I_D + 2 * I_1;
    for (int it = gw; it < NITEMS; it += NGW) {
        int r = it;
        if (r < I_IN) { const float* W = F.A.in[(I_WIN) + F.z]; transpose_item([&](int n) -> const float* { const int s = zcol_src(n); return s < 0 ? nullptr : W + s; }, 5048, ((bf16_t*)(F.wsb + WS_WIN)), 1024, scr, r / 160, r % 160, lane); continue; } r -= I_IN;
        if (r < I_A) { const float* W = F.A.in[(I_WBA) + F.z]; transpose_item([&](int n) -> const float* { return W + n; }, 1024, ((bf16_t*)(F.wsb + WS_WA)), 512, scr, r / 32, r % 32, lane); continue; } r -= I_A;
        if (r < I_A) { const float* W = F.A.in[(I_WBB) + F.z]; transpose_item([&](int n) -> const float* { return W + n; }, 1024, ((bf16_t*)(F.wsb + WS_WB)), 512, scr, r / 32, r % 32, lane); continue; } r -= I_A;
        if (r < I_O) { const float* W = F.A.in[(I_WOUT) + F.z]; transpose_item([&](int n) -> const float* { return W + n; }, 1024, ((bf16_t*)(F.wsb + WS_WOUT)), 1024, scr, r / 32, r % 32, lane); continue; } r -= I_O;
        if (r < I_GU) { const float* Wg = F.A.in[(I_WGATE) + F.z]; const float* Wu = F.A.in[(I_WUP) + F.z];
            transpose_item([&](int n) -> const float* { const int tl = n >> 8, w = n & 255; return (w < 128) ? Wg + tl * 128 + w : Wu + tl * 128 + (w - 128); }, DFF, ((bf16_t*)(F.wsb + WS_WGU)), 1024, scr, r / 176, r % 176, lane); continue; } r -= I_GU;
        if (r < I_D) { const float* W = F.A.in[(I_WDOWN) + F.z]; transpose_item([&](int n) -> const float* { return W + n; }, 1024, ((bf16_t*)(F.wsb + WS_WD)), DFF, scr, r / 32, r % 32, lane); continue; } r -= I_D;
        if (r < I_1) { const float* W = F.A.in[(I_W1K) + F.z]; transpose_item([&](int n) -> const float* { return W + n; }, 256, ((bf16_t*)(F.wsb + WS_W1K)), 2048, scr, r / 8, r % 8, lane); continue; } r -= I_1;
        { const float* W = F.A.in[(I_W1V) + F.z]; transpose_item([&](int n) -> const float* { return W + n; }, 256, ((bf16_t*)(F.wsb + WS_W1V)), 2048, scr, r / 8, r % 8, lane); }
    }
    { const float* gp = F.A.in[(I_N1PRE) + F.z];
      f32x4 gv[4];
#pragma unroll
      for (int j = 0; j < 4; ++j) gv[j] = ((const f32x4*)gp)[lane + 64 * j];
      for (int m = gw; m < NTOK; m += 4 * NGW) {
        f32x4 v[4][4]; float ss[4];
#pragma unroll
        for (int q = 0; q < 4; ++q) { const f32x4* xr = (const f32x4*)(F.A.in[(I_X) + F.z] + (size_t)(m + q * NGW) * DM) + lane;
#pragma unroll
            for (int j = 0; j < 4; ++j) v[q][j] = xr[64 * j]; }
#pragma unroll
        for (int q = 0; q < 4; ++q) { float s = 0.f;
#pragma unroll
            for (int j = 0; j < 4; ++j) s += (v[q][j].x * v[q][j].x + v[q][j].y * v[q][j].y) + (v[q][j].z * v[q][j].z + v[q][j].w * v[q][j].w);
            ss[q] = __builtin_amdgcn_rsqf(wave_sum(s) * (1.f / DM) + 1e-6f); }
#pragma unroll
        for (int q = 0; q < 4; ++q) { u32x2* o8 = (u32x2*)(((bf16_t*)(F.wsb + WS_XN)) + (size_t)(m + q * NGW) * DM) + lane; const float rs = ss[q];
#pragma unroll
            for (int j = 0; j < 4; ++j) { u32x2 w; w.x = cvtpk(v[q][j].x * rs * gv[j].x, v[q][j].y * rs * gv[j].y); w.y = cvtpk(v[q][j].z * rs * gv[j].z, v[q][j].w * rs * gv[j].w); o8[64 * j] = w; } } } }
    { const int gt = gw * 64 + lane, NT = NGW * 64;
      for (int i = gt; i < SEQ * 32; i += NT) { const int t = i >> 5, f = i & 31; const float inv = 1.0f / powf(10000.0f, (float)(2 * f) / 64.0f); const float ang = (float)t * inv; float sn, cs; sincosf(ang, &sn, &cs); ((float*)(F.wsb + WS_ROPE))[2 * i] = cs; ((float*)(F.wsb + WS_ROPE))[2 * i + 1] = sn; } }
    { const int gt = gw * 64 + lane, NT = NGW * 64;
      for (int i = gt; i < 512 * 32; i += NT) { const int cch = i >> 5, r = i & 31; ((bf16_t*)(F.wsb + WS_W2W))[i] = f2bf(F.A.in[(I_WW2) + F.z][(size_t)r * 512 + cch]); ((bf16_t*)(F.wsb + WS_W2A))[i] = f2bf(F.A.in[(I_WA2) + F.z][(size_t)r * 512 + cch]); }
      for (int i = gt; i < 512 * 96; i += NT) { const int cch = i / 96, r = i % 96; ((bf16_t*)(F.wsb + WS_WGT))[i] = f2bf(F.A.in[(I_WG2) + F.z][(size_t)r * 512 + cch]); } }
    for (int o = gw; o < 512; o += NGW) { const int kv = o >> 8, j = o & 255; const float* pe = F.A.in[(kv ? I_PEV : I_PEK) + F.z]; const float* w1 = F.A.in[(kv ? I_W1V : I_W1K) + F.z]; float s = 0.f;
#pragma unroll
        for (int i = 0; i < 32; ++i) { const int k = lane + 64 * i; s += pe[k] * w1[(size_t)k * 256 + j]; }
        s = wave_sum(s); if (lane == 0) ((float*)(F.wsb + WS_B1P))[o] = s + F.A.in[(kv ? I_B1V : I_B1K) + F.z][j]; }
}

__device__ __forceinline__ void cmp_stage2(Frame& F0, int unit) {
    PHASE_FRAME(F, F0);
    const int lane = F.lane;
    for (int r_ = F.wave; r_ < 256; r_ += NWAVES) {
        const int kv = unit >> 4, m = (unit & 15) * 256 + r_, bg = m >> 9, n = m & 511;
        const float* w2 = F.A.in[(kv ? I_W2V : I_W2K) + F.z]; const int dcol = kv ? lane : rope_perm64(lane);
        const bf16_t* h = ((bf16_t*)(F.wsb + WS_HID)) + ((size_t)kv * 4096 + m) * 256; float s = 0.f;
        const unsigned hv0 = ((const unsigned*)h)[lane], hv1 = ((const unsigned*)h)[64 + lane];
#pragma unroll 8
        for (int j = 0; j < 64; ++j) { const unsigned a = __shfl(hv0, j), b = __shfl(hv1, j);
            s += bflo(a) * w2[(size_t)(2 * j) * 64 + dcol] + bfhi(a) * w2[(size_t)(2 * j + 1) * 64 + dcol] + bflo(b) * w2[(size_t)(128 + 2 * j) * 64 + dcol] + bfhi(b) * w2[(size_t)(129 + 2 * j) * 64 + dcol]; }
        if (n == 511) s = 0.f;
        if (kv == 0) ((bf16_t*)(F.wsb + WS_KC))[((size_t)bg * 512 + n) * 64 + lane] = f2bf(s); else ((bf16_t*)(F.wsb + WS_VCT))[((size_t)bg * 64 + lane) * 512 + vt_keypos(n)] = f2bf(s);
    }
}

__device__ __forceinline__ void rwkv_prep(Frame& F0) {
    PHASE_FRAME(F, F0);
    const int lane = F.lane, c0 = lane * 8;
    const float* ww2 = F.A.in[(I_WW2) + F.z]; const float* wa2 = F.A.in[(I_WA2) + F.z];
    for (int it = F.gw; it < NTOK / 4; it += F.NGW) {
        const int t0 = it * 4; float val[4];
#pragma unroll
        for (int q = 0; q < 4; ++q) { const int t = t0 + q; const float z = bf2f(((bf16_t*)(F.wsb + WS_ZA))[(size_t)t * ZP + C_WLO + lane]); const float zp = (t & (SEQ - 1)) ? bf2f(((bf16_t*)(F.wsb + WS_ZA))[(size_t)(t - 1) * ZP + C_WLO + lane]) : 0.f;
            const float mu = (lane < 32) ? F.A.in[(I_MUW) + F.z][lane] : F.A.in[(I_MUA) + F.z][lane - 32]; const float v = z + (zp - z) * mu; val[q] = (lane < 32) ? tanhf(v) : v; }
        float aw[4][8], aa[4][8];
#pragma unroll
        for (int q = 0; q < 4; ++q)
#pragma unroll
            for (int e = 0; e < 8; ++e) { aw[q][e] = 0.f; aa[q][e] = 0.f; }
#pragma unroll 4
        for (int i = 0; i < 32; ++i) {
            const f32x4 w0a = *(const f32x4*)(ww2 + (size_t)i * 512 + c0), w0b = *(const f32x4*)(ww2 + (size_t)i * 512 + c0 + 4);
            const f32x4 w1a = *(const f32x4*)(wa2 + (size_t)i * 512 + c0), w1b = *(const f32x4*)(wa2 + (size_t)i * 512 + c0 + 4);
#pragma unroll
            for (int q = 0; q < 4; ++q) { const float wv = __shfl(val[q], i), av = __shfl(val[q], 32 + i);
#pragma unroll
                for (int e = 0; e < 4; ++e) { aw[q][e] += wv * w0a[e]; aw[q][4 + e] += wv * w0b[e]; aa[q][e] += av * w1a[e]; aa[q][4 + e] += av * w1b[e]; } }
        }
        const f32x4 w0v0 = *(const f32x4*)(F.A.in[(I_W0) + F.z] + c0), w0v1 = *(const f32x4*)(F.A.in[(I_W0) + F.z] + c0 + 4), a0v0 = *(const f32x4*)(F.A.in[(I_A0) + F.z] + c0), a0v1 = *(const f32x4*)(F.A.in[(I_A0) + F.z] + c0 + 4);
#pragma unroll
        for (int q = 0; q < 4; ++q) { const int t = t0 + q; float lw[8]; unsigned ap[4];
#pragma unroll
            for (int e = 0; e < 8; ++e) { const float wl = ((e < 4) ? w0v0[e & 3] : w0v1[e & 3]) + aw[q][e];
                const float nx = -wl; const float sp = fmaxf(nx, 0.f) + log1pf(expf(-fabsf(nx)));
                lw[e] = -expf(-sp - 0.5f) * LOG2E; }
            *(f32x4*)(((float*)(F.wsb + WS_XN)) + (size_t)t * 512 + c0) = (f32x4){lw[0], lw[1], lw[2], lw[3]}; *(f32x4*)(((float*)(F.wsb + WS_XN)) + (size_t)t * 512 + c0 + 4) = (f32x4){lw[4], lw[5], lw[6], lw[7]};
#pragma unroll
            for (int e = 0; e < 4; ++e) { const float x0 = ((2 * e < 4) ? a0v0[(2 * e) & 3] : a0v1[(2 * e) & 3]) + aa[q][2 * e], x1 = ((2 * e + 1 < 4) ? a0v0[(2 * e + 1) & 3] : a0v1[(2 * e + 1) & 3]) + aa[q][2 * e + 1];
                ap[e] = cvtpk(sigmoidf_(x0), sigmoidf_(x1)); }
            *(u32x4*)(((bf16_t*)(F.wsb + WS_AA)) + (size_t)t * 512 + c0) = (u32x4){ap[0], ap[1], ap[2], ap[3]};
        }
    }
}

#define LDS_BAR() do { asm volatile("s_waitcnt lgkmcnt(0)" ::: "memory"); __builtin_amdgcn_s_barrier(); asm volatile("" ::: "memory"); } while (0)
#define LDS_SPIN_GE(PTR, TGT) do { while ((unsigned)__builtin_amdgcn_readfirstlane((int)*(volatile LAS unsigned*)(PTR)) < (unsigned)(TGT)) __builtin_amdgcn_s_sleep(1); asm volatile("" ::: "memory"); } while (0)
#define LDS_SIGNAL(LANE, PTR) do { asm volatile("s_waitcnt lgkmcnt(0)" ::: "memory"); if ((LANE) == 0) __hip_atomic_fetch_add((LAS unsigned*)(PTR), 1u, __ATOMIC_RELAXED, __HIP_MEMORY_SCOPE_WORKGROUP); asm volatile("" ::: "memory"); } while (0)
__device__ __forceinline__ int nsa_off(int row, int chunk) { return row * 128 + ((chunk ^ ((row >> 1) & 7)) << 4); }
constexpr int CP = 72, SLOT = 8192;
constexpr int L_ATR = 0, L_XA = 1 * SLOT, L_RTR = 3 * SLOT, L_XB = 4 * SLOT, L_BTR = 4 * SLOT, L_KTR = 5 * SLOT, L_BHC = 6 * SLOT, L_KCC = 7 * SLOT, L_VC = 8 * SLOT,
              L_PAR = 9 * SLOT, L_PAC = 10 * SLOT, L_PBC = 11 * SLOT, L_PBR = L_ATR, L_MBR = 12 * SLOT, L_SEG = 13 * SLOT + 1024, L_GC = L_SEG + 2048;
constexpr int CH_GT = 0, CH_WY = 8192, CH_HT = 16384, CH_Y0 = 24576, CH_BYTES = 32768;
__device__ __forceinline__ bf16x8 ldfrag(LAS unsigned char* L, int buf, int row0, int ks, int c, int g) { return *(const LAS bf16x8*)(L + buf + nsa_off(row0 + c, 4 * ks + g)); }
__device__ __forceinline__ void store_T(LAS unsigned char* L, int buf, int m0, int n0, const f32x4 v, int c, int g) { u32x2 w; w.x = cvtpk(v[0], v[1]); w.y = cvtpk(v[2], v[3]); *(LAS u32x2*)(L + buf + nsa_off(n0 + c, (m0 >> 3) + (g >> 1)) + 8 * (g & 1)) = w; }
__device__ __forceinline__ void store_R(LAS unsigned char* L, int buf, int m0, int n0, const f32x4 v, int c, int g) {
#pragma unroll
    for (int r = 0; r < 4; ++r) *(LAS bf16_t*)(L + buf + nsa_off(m0 + 4 * g + r, (n0 + c) >> 3) + 2 * ((n0 + c) & 7)) = f2bf(v[r]); }
__device__ __forceinline__ f32x4 ld_c4(LAS unsigned char* L, int buf, int row, int col0) { const u32x2 w = *(const LAS u32x2*)(L + buf + nsa_off(row, col0 >> 3) + 2 * (col0 & 7)); return (f32x4){bflo(w.x), bfhi(w.x), bflo(w.y), bfhi(w.y)}; }
#define MF16(a, b, cc) __builtin_amdgcn_mfma_f32_16x16x32_bf16(a, b, cc, 0, 0, 0)

__device__ __forceinline__ void rwkv_chunk_phase(Frame& F0, unsigned char* CH) {
    PHASE_FRAME(F, F0);
    const int lane = F.lane, w = F.wave, c = lane & 15, g = lane >> 4, mi = w >> 1, half = w & 1;
    LAS unsigned char* L = F.lds;
    const f32x4 Z4 = (f32x4){0.f, 0.f, 0.f, 0.f};
    LAS int* qslot = (LAS int*)(L + L_SEG + 4096);
    struct ChunkIn { u32x2 wc, wp, ac, ap, gc[3], gp[3]; bf16_t rz[9], kz[9], vz[9]; };
#define CHUNK_LOAD(D, CID) do { const int blk_ = (CID) >> 3, h_ = (CID) & 7, b_ = blk_ >> 7, ch_ = blk_ & 127; \
        { const int t_ = F.tid >> 3, q8_ = F.tid & 7; const size_t tk_ = (size_t)b_ * SEQ + 64 * ch_ + t_; const bool hp_ = (64 * ch_ + t_) != 0; \
          const bf16_t* zr_ = ((bf16_t*)(F.wsb + WS_ZA)) + tk_ * ZP; const bf16_t* zq_ = zr_ - ZP; const u32x2 z0_ = (u32x2){0u, 0u}; \
          D.wc = *(const u32x2*)(zr_ + C_WLO + 4 * q8_); D.wp = hp_ ? *(const u32x2*)(zq_ + C_WLO + 4 * q8_) : z0_; D.ac = *(const u32x2*)(zr_ + C_ALO + 4 * q8_); D.ap = hp_ ? *(const u32x2*)(zq_ + C_ALO + 4 * q8_) : z0_; \
          _Pragma("unroll") for (int k3_ = 0; k3_ < 3; ++k3_) { const int col_ = 12 * q8_ + 4 * k3_; D.gc[k3_] = *(const u32x2*)(zr_ + C_GLO + col_); D.gp[k3_] = hp_ ? *(const u32x2*)(zq_ + C_GLO + col_) : z0_; } } \
        { const int hj_ = h_ * 64 + lane; const size_t tok0_ = (size_t)b_ * SEQ + 64 * ch_ + 8 * w; const bool hp_ = (ch_ != 0) || (w != 0); const bf16_t* za_ = (bf16_t*)(F.wsb + WS_ZA); \
          D.rz[0] = hp_ ? za_[(tok0_ - 1) * ZP + C_R + hj_] : (bf16_t)0; D.kz[0] = hp_ ? za_[(tok0_ - 1) * ZP + C_K + hj_] : (bf16_t)0; D.vz[0] = hp_ ? za_[(tok0_ - 1) * ZP + C_V + hj_] : (bf16_t)0; \
          _Pragma("unroll") for (int s_ = 0; s_ < 8; ++s_) { const size_t tk_ = tok0_ + s_; D.rz[s_ + 1] = za_[tk_ * ZP + C_R + hj_]; D.kz[s_ + 1] = za_[tk_ * ZP + C_K + hj_]; D.vz[s_ + 1] = za_[tk_ * ZP + C_V + hj_]; } } } while (0)
    ChunkIn cin;
    const int hq = F.vcu & 7; unsigned* qhead = F.ctl + CW_Q_CHUNK + 64 * hq; LAS int* qslot2 = (LAS int*)(L + L_SEG + 4096);
    __syncthreads();
    if (F.tid == 0) qslot2[0] = (int)__hip_atomic_fetch_add(qhead, 1u, RLX_AGENT);
    __syncthreads();
    int blk = qslot2[0]; int nticket = 0;
    for (int it_ = 0;; ++it_) {
        if (blk >= 512) break;
        int h = hq; asm volatile("" : "+s"(h));
        CHUNK_LOAD(cin, blk * 8 + h);
        const int b = blk >> 7, chunk = blk & 127, chain = b * 8 + h;
        unsigned char* CB = CH + ((size_t)(chain * 128 + chunk)) * CH_BYTES;
        bf16x8 hbW[2], hbA[2], hbG[2][3]; float hw0[2], ha0[2];
        constexpr int L_TW = 3 * SLOT, L_TA = L_TW + 64 * 80, L_TG = L_TA + 64 * 80, L_LWS = 9 * SLOT, L_AAS = L_LWS + 64 * 65 * 4;
        {
            const int t = F.tid >> 3, q8 = F.tid & 7;
            { const u32x2 cw = cin.wc, pw = cin.wp; const f32x4 mu = *(const f32x4*)(F.A.in[(I_MUW) + F.z] + 4 * q8);
              float v[4]; const float c4[4] = {bflo(cw.x), bfhi(cw.x), bflo(cw.y), bfhi(cw.y)}, p4[4] = {bflo(pw.x), bfhi(pw.x), bflo(pw.y), bfhi(pw.y)};
#pragma unroll
              for (int e = 0; e < 4; ++e) { const float x_ = c4[e] + (p4[e] - c4[e]) * mu[e]; v[e] = 1.0f - 2.0f * frcp(1.0f + __expf(2.0f * x_)); }
              *(LAS u32x2*)(L + L_TW + t * 80 + 8 * q8) = (u32x2){cvtpk(v[0], v[1]), cvtpk(v[2], v[3])}; }
            { const u32x2 cw = cin.ac, pw = cin.ap; const f32x4 mu = *(const f32x4*)(F.A.in[(I_MUA) + F.z] + 4 * q8);
              float v[4]; const float c4[4] = {bflo(cw.x), bfhi(cw.x), bflo(cw.y), bfhi(cw.y)}, p4[4] = {bflo(pw.x), bfhi(pw.x), bflo(pw.y), bfhi(pw.y)};
#pragma unroll
              for (int e = 0; e < 4; ++e) v[e] = c4[e] + (p4[e] - c4[e]) * mu[e];
              *(LAS u32x2*)(L + L_TA + t * 80 + 8 * q8) = (u32x2){cvtpk(v[0], v[1]), cvtpk(v[2], v[3])}; }
#pragma unroll
            for (int k3 = 0; k3 < 3; ++k3) { const int col = 12 * q8 + 4 * k3; const u32x2 cw = cin.gc[k3], pw = cin.gp[k3]; const f32x4 mu = *(const f32x4*)(F.A.in[(I_MUG) + F.z] + col);
              float v[4]; const float c4[4] = {bflo(cw.x), bfhi(cw.x), bflo(cw.y), bfhi(cw.y)}, p4[4] = {bflo(pw.x), bfhi(pw.x), bflo(pw.y), bfhi(pw.y)};
#pragma unroll
              for (int e = 0; e < 4; ++e) v[e] = sigmoidf_(c4[e] + (p4[e] - c4[e]) * mu[e]);
              *(LAS u32x2*)(L + L_TG + t * 208 + 2 * col) = (u32x2){cvtpk(v[0], v[1]), cvtpk(v[2], v[3])}; }
#pragma unroll
        for (int q = 0; q < 2; ++q) { const int hc = h * 64 + 16 * (2 * half + q) + c;
        hbW[q] = *(const bf16x8*)(((bf16_t*)(F.wsb + WS_W2W)) + hc * 32 + 8 * g); hbA[q] = *(const bf16x8*)(((bf16_t*)(F.wsb + WS_W2A)) + hc * 32 + 8 * g);
#pragma unroll
        for (int ks = 0; ks < 3; ++ks) hbG[q][ks] = *(const bf16x8*)(((bf16_t*)(F.wsb + WS_WGT)) + hc * 96 + 32 * ks + 8 * g);
        hw0[q] = F.A.in[(I_W0) + F.z][hc]; ha0[q] = F.A.in[(I_A0) + F.z][hc]; }
            LDS_BAR();
        }
        {
            const bf16x8 aW = *(const LAS bf16x8*)(L + L_TW + (16 * mi + c) * 80 + 16 * g), aA = *(const LAS bf16x8*)(L + L_TA + (16 * mi + c) * 80 + 16 * g);
            bf16x8 aG[3];
#pragma unroll
            for (int ks = 0; ks < 3; ++ks) aG[ks] = *(const LAS bf16x8*)(L + L_TG + (16 * mi + c) * 208 + 64 * ks + 16 * g);
#pragma unroll
            for (int q = 0; q < 2; ++q) { const int ni = 2 * half + q, hc = h * 64 + 16 * ni + c;
                const bf16x8 bW = hbW[q], bA = hbA[q];
                const f32x4 dw = MF16(aW, bW, Z4), da = MF16(aA, bA, Z4);
                f32x4 dg = Z4;
#pragma unroll
                for (int ks = 0; ks < 3; ++ks) dg = MF16(aG[ks], hbG[q][ks], dg);
                const float w0c = hw0[q], a0c = ha0[q];
                bf16_t* gp = ((bf16_t*)(F.wsb + WS_XN)) + ((size_t)b * SEQ + 64 * chunk + 16 * mi + 4 * g) * 1024 + 512 + hc;
#pragma unroll
                for (int r = 0; r < 4; ++r) { const float wl = w0c + dw[r]; const float nx = -wl; const float sp = fmaxf(nx, 0.f) + __logf(1.0f + __expf(-fabsf(nx)));
                    ((LAS float*)(L + L_LWS))[(16 * mi + 4 * g + r) * 65 + 16 * ni + c] = -__expf(-sp - 0.5f) * LOG2E;
                    ((LAS float*)(L + L_AAS))[(16 * mi + 4 * g + r) * 65 + 16 * ni + c] = sigmoidf_(a0c + da[r]);
                    gp[(size_t)r * 1024] = f2bf(dg[r]); } }
            LDS_BAR();
        }
        {
            const int j = lane, seg = w, hj = h * 64 + j; const size_t tok0 = (size_t)b * SEQ + 64 * chunk + 8 * seg;
            const float mur = F.A.in[(I_MUR) + F.z][hj], muk = F.A.in[(I_MUK) + F.z][hj], muv = F.A.in[(I_MUV) + F.z][hj], kkc = F.A.in[(I_KK) + F.z][hj], kac = F.A.in[(I_KA) + F.z][hj], rkc = F.A.in[(I_RK) + F.z][hj];
            float rz[9], kz[9], vz[9], lw[8], aa[8];
            rz[0] = bf2f(cin.rz[0]); kz[0] = bf2f(cin.kz[0]); vz[0] = bf2f(cin.vz[0]);
#pragma unroll
            for (int s = 0; s < 8; ++s) { rz[s + 1] = bf2f(cin.rz[s + 1]); kz[s + 1] = bf2f(cin.kz[s + 1]); vz[s + 1] = bf2f(cin.vz[s + 1]);
                lw[s] = ((LAS float*)(L + L_LWS))[(8 * seg + s) * 65 + j]; aa[s] = ((LAS float*)(L + L_AAS))[(8 * seg + s) * 65 + j]; }
            float cum[8], kk[8], kh[8], rs[8]; float run = 0.f; unsigned vpk[4];
#pragma unroll
            for (int s = 0; s < 8; ++s) { run += lw[s]; cum[s] = run;
                rs[s] = rz[s + 1] + (rz[s] - rz[s + 1]) * mur; const float ks = kz[s + 1] + (kz[s] - kz[s + 1]) * muk;
                const float kq = ks * kkc; const float ssq = dpp_sum(kq * kq); kk[s] = kq * frcp(fmaxf(sqrtf(ssq), 1e-12f));
                kh[s] = ks * (1.0f + (aa[s] - 1.0f) * kac);
                const float bsum = dpp_sum(rs[s] * kh[s] * rkc); if (lane == 0) ((float*)(F.wsb + WS_BON))[(tok0 + s) * 8 + h] = bsum; }
#pragma unroll
            for (int s = 0; s < 4; ++s) { const float v0 = vz[2 * s + 1] + (vz[2 * s] - vz[2 * s + 1]) * muv, v1 = vz[2 * s + 2] + (vz[2 * s + 1] - vz[2 * s + 2]) * muv; vpk[s] = cvtpk(v0, v1); }
            *(LAS u32x4*)(L + L_VC + nsa_off(j, seg)) = (u32x4){vpk[0], vpk[1], vpk[2], vpk[3]};
            ((LAS float*)(L + L_SEG))[seg * 64 + j] = run;
            LDS_BAR();
            float off = 0.f, tot = 0.f;
#pragma unroll
            for (int s = 0; s < 8; ++s) { const float x = ((LAS float*)(L + L_SEG))[s * 64 + j]; tot += x; off += (s < seg) ? x : 0.f; }
            if (seg == 0) ((LAS float*)(L + L_GC))[j] = fast_exp2(tot);
            float at[8], bh[8], kc[8];
#pragma unroll
            for (int s = 0; s < 8; ++s) { const float cs = cum[s] + off; const float ep = fast_exp2(cs), en = fast_exp2(-cs), er = fast_exp2(tot - cs); const int t = 8 * seg + s;
                const float beta = kk[s] * aa[s]; at[s] = kk[s] * fast_exp2(cs - lw[s]); bh[s] = beta * er; kc[s] = kh[s] * er;
                { const int o_ = nsa_off(t, j >> 3) + 2 * (j & 7); *(LAS bf16_t*)(L + L_ATR + o_) = f2bf(at[s]); *(LAS bf16_t*)(L + L_RTR + o_) = f2bf(rs[s] * ep);
                *(LAS bf16_t*)(L + L_BTR + o_) = f2bf(beta * en); *(LAS bf16_t*)(L + L_KTR + o_) = f2bf(kh[s] * en); } }
            *(LAS u32x4*)(L + L_XA + nsa_off(j, seg)) = (u32x4){cvtpk(at[0], at[1]), cvtpk(at[2], at[3]), cvtpk(at[4], at[5]), cvtpk(at[6], at[7])};
            *(LAS u32x4*)(L + L_BHC + nsa_off(j, seg)) = (u32x4){cvtpk(bh[0], bh[1]), cvtpk(bh[2], bh[3]), cvtpk(bh[4], bh[5]), cvtpk(bh[6], bh[7])};
            *(LAS u32x4*)(L + L_KCC + nsa_off(j, seg)) = (u32x4){cvtpk(kc[0], kc[1]), cvtpk(kc[2], kc[3]), cvtpk(kc[4], kc[5]), cvtpk(kc[6], kc[7])};
            LDS_BAR();
        }
        if (F.tid == 0) nticket = (int)__hip_atomic_fetch_add(qhead, 1u, RLX_AGENT);
        f32x4 X[4], Mk[2];
        {
            bf16x8 aA[2]; aA[0] = ldfrag(L, L_ATR, 16 * mi, 0, c, g); aA[1] = ldfrag(L, L_ATR, 16 * mi, 1, c, g);
#pragma unroll
            for (int q = 0; q < 4; ++q) {
                const int bsrc = half ? L_KTR : L_BTR;
                f32x4 t = MF16(aA[0], ldfrag(L, bsrc, 16 * q, 0, c, g), Z4); t = MF16(aA[1], ldfrag(L, bsrc, 16 * q, 1, c, g), t);
#pragma unroll
                for (int r = 0; r < 4; ++r) t[r] = ((16 * q + c) < (16 * mi + 4 * g + r)) ? t[r] : 0.f;
                if (half == 0) { const f32x4 p0 = -t; store_T(L, L_PAC, 16 * mi, 16 * q, p0, c, g); store_R(L, L_PAR, 16 * mi, 16 * q, p0, c, g);
                    X[q] = ld_c4(L, L_XA, 16 * q + c, 16 * mi + 4 * g); }
                else { X[q] = t; store_T(L, L_XA + 8192, 16 * mi, 16 * q, t, c, g); }
            }
            bf16x8 aB[2], aK[2]; aB[0] = ldfrag(L, L_BTR, 16 * mi, 0, c, g); aB[1] = ldfrag(L, L_BTR, 16 * mi, 1, c, g); aK[0] = ldfrag(L, L_KTR, 16 * mi, 0, c, g); aK[1] = ldfrag(L, L_KTR, 16 * mi, 1, c, g);
#pragma unroll
            for (int q = 0; q < 2; ++q) { const int n0 = 16 * (2 * half + q); const bf16x8 bR0 = ldfrag(L, L_RTR, n0, 0, c, g), bR1 = ldfrag(L, L_RTR, n0, 1, c, g);
                f32x4 rb = MF16(aB[0], bR0, Z4); rb = MF16(aB[1], bR1, rb); f32x4 rk = MF16(aK[0], bR0, Z4); rk = MF16(aK[1], bR1, rk);
#pragma unroll
                for (int r = 0; r < 4; ++r) { const bool keep = (16 * mi + 4 * g + r) <= (n0 + c); rb[r] = keep ? rb[r] : 0.f; rk[r] = keep ? rk[r] : 0.f; }
                store_T(L, L_MBR, 16 * mi, n0, rb, c, g); Mk[q] = rk; }
            LDS_BAR();
        }
#pragma unroll
        for (int s = 0; s < 6; ++s) {
            const int Pr = (s & 1) ? L_PBR : L_PAR, Pc = (s & 1) ? L_PBC : L_PAC, Xc = (s & 1) ? L_XB : L_XA;
            const int Prn = (s & 1) ? L_PAR : L_PBR, Pcn = (s & 1) ? L_PAC : L_PBC, Xn = (s & 1) ? L_XA : L_XB;
            const bf16x8 a0 = ldfrag(L, Pr, 16 * mi, 0, c, g), a1 = ldfrag(L, Pr, 16 * mi, 1, c, g);
#pragma unroll
            for (int q = 0; q < 4; ++q) { const int n0 = 16 * (4 * half + q); X[q] = MF16(a0, ldfrag(L, Xc, n0, 0, c, g), X[q]); X[q] = MF16(a1, ldfrag(L, Xc, n0, 1, c, g), X[q]); }
            f32x4 Pn[2];
            if (s < 5) {
#pragma unroll
                for (int q = 0; q < 2; ++q) { const int n0 = 16 * (2 * half + q); Pn[q] = MF16(a0, ldfrag(L, Pc, n0, 0, c, g), Z4); Pn[q] = MF16(a1, ldfrag(L, Pc, n0, 1, c, g), Pn[q]); }
            }
#pragma unroll
            for (int q = 0; q < 4; ++q) store_T(L, Xn, 16 * mi, 16 * (4 * half + q), (s == 5) ? -X[q] : X[q], c, g);
            if (s < 5) {
#pragma unroll
                for (int q = 0; q < 2; ++q) { store_T(L, Pcn, 16 * mi, 16 * (2 * half + q), Pn[q], c, g); store_R(L, Prn, 16 * mi, 16 * (2 * half + q), Pn[q], c, g); }
            }
            LDS_BAR();
        }
        {
            bf16x8 aN1[2], aN2[2]; aN1[0] = ldfrag(L, L_XA, 16 * mi, 0, c, g); aN1[1] = ldfrag(L, L_XA, 16 * mi, 1, c, g); aN2[0] = ldfrag(L, L_XA, 64 + 16 * mi, 0, c, g); aN2[1] = ldfrag(L, L_XA, 64 + 16 * mi, 1, c, g);
#pragma unroll
            for (int q = 0; q < 2; ++q) { const int n0 = 16 * (2 * half + q);
                const bf16x8 bM0 = ldfrag(L, L_MBR, n0, 0, c, g), bM1 = ldfrag(L, L_MBR, n0, 1, c, g), bH0 = ldfrag(L, L_BHC, n0, 0, c, g), bH1 = ldfrag(L, L_BHC, n0, 1, c, g);
                f32x4 wy = ld_c4(L, L_RTR, n0 + c, 16 * mi + 4 * g); wy = MF16(aN1[0], bM0, wy); wy = MF16(aN1[1], bM1, wy);
                { u32x2 ww; ww.x = cvtpk(wy[0], wy[1]); ww.y = cvtpk(wy[2], wy[3]); *(u32x2*)(CB + CH_WY + (((2 * half + q) * 2 + (mi >> 1)) * 64 + lane) * 16 + (mi & 1) * 8) = ww; }
                f32x4 py = Mk[q]; py = MF16(aN2[0], bM0, py); py = MF16(aN2[1], bM1, py); store_T(L, L_PAR, 16 * mi, n0, py, c, g);
                f32x4 gt = MF16(aN1[0], bH0, Z4); gt = MF16(aN1[1], bH1, gt); const float gcv = ((LAS float*)(L + L_GC))[n0 + c];
#pragma unroll
                for (int r = 0; r < 4; ++r) gt[r] += ((16 * mi + 4 * g + r) == (n0 + c)) ? gcv : 0.f;
                { u32x2 ww; ww.x = cvtpk(gt[0], gt[1]); ww.y = cvtpk(gt[2], gt[3]); *(u32x2*)(CB + CH_GT + (((2 * half + q) * 2 + (mi >> 1)) * 64 + lane) * 16 + (mi & 1) * 8) = ww; }
                f32x4 zh = ld_c4(L, L_KCC, n0 + c, 16 * mi + 4 * g); zh = MF16(aN2[0], bH0, zh); zh = MF16(aN2[1], bH1, zh); store_T(L, L_PAC, 16 * mi, n0, zh, c, g); }
            LDS_BAR();
        }
        {
            const bf16x8 aZ0 = ldfrag(L, L_PAC, 16 * mi, 0, c, g), aZ1 = ldfrag(L, L_PAC, 16 * mi, 1, c, g), aP0 = ldfrag(L, L_PAR, 16 * mi, 0, c, g), aP1 = ldfrag(L, L_PAR, 16 * mi, 1, c, g);
#pragma unroll
            for (int q = 0; q < 2; ++q) { const int ni = 2 * half + q; const bf16x8 bV0 = ldfrag(L, L_VC, 16 * ni, 0, c, g), bV1 = ldfrag(L, L_VC, 16 * ni, 1, c, g);
                f32x4 ht = MF16(aZ0, bV0, Z4); ht = MF16(aZ1, bV1, ht); f32x4 y0 = MF16(aP0, bV0, Z4); y0 = MF16(aP1, bV1, y0);
                u32x2 w1; w1.x = cvtpk(ht[0], ht[1]); w1.y = cvtpk(ht[2], ht[3]); *(u32x2*)(CB + CH_HT + ((mi * 4 + ni) * 64 + lane) * 8) = w1;
                u32x2 w2; w2.x = cvtpk(y0[0], y0[1]); w2.y = cvtpk(y0[2], y0[3]); *(u32x2*)(CB + CH_Y0 + ((mi * 4 + ni) * 64 + lane) * 8) = w2; }
            if (F.tid == 0) qslot2[(it_ + 1) & 1] = nticket;
            LDS_BAR();
        }
        blk = qslot2[(it_ + 1) & 1];
    }
#undef CHUNK_LOAD
}
constexpr int SC_SLOT = 32768, SC_CTR = LDS_BYTES - 64;
__device__ __forceinline__ void rwkv_scan_serial(Frame& F0, const unsigned char* CH, int chain) {
    PHASE_FRAME(F, F0);
    const int lane = F.lane, w = F.wave, c = lane & 15, g = lane >> 4, b = chain >> 3, h = chain & 7;
    LAS unsigned char* L = F.lds; LAS unsigned* rdy = (LAS unsigned*)(L + SC_CTR); LAS unsigned* dne = rdy + 4;
    if (F.tid < 8) rdy[F.tid] = 0u;
    LDS_BAR();
    const GAS unsigned char* CB0 = (const GAS unsigned char*)CH + (size_t)chain * 128 * CH_BYTES;
    if (w >= 4) {
        const int j = w - 4; const GAS unsigned char* src = CB0 + j * 8192 + lane * 16;
#define SC_ISSUE(K) do { const int sl_ = (K) & 3; _Pragma("unroll") for (int i_ = 0; i_ < 8; ++i_) \
            __builtin_amdgcn_global_load_lds((const GAS unsigned*)(src + (size_t)(K) * CH_BYTES + i_ * 1024), (LAS unsigned*)(L + sl_ * SC_SLOT + j * 8192 + i_ * 1024), 16, 0, 0); } while (0)
        SC_ISSUE(0); SC_ISSUE(1); SC_ISSUE(2);
#pragma unroll 1
        for (int k = 3; k < 128; ++k) {
            if (k >= 4) LDS_SPIN_GE(dne + (k & 3), 4u * (unsigned)(k >> 2));
            SC_ISSUE(k);
            asm volatile("s_waitcnt vmcnt(24)" ::: "memory"); LDS_SIGNAL(lane, rdy + ((k - 3) & 3));
        }
        asm volatile("s_waitcnt vmcnt(16)" ::: "memory"); LDS_SIGNAL(lane, rdy + (125 & 3));
        asm volatile("s_waitcnt vmcnt(8)" ::: "memory"); LDS_SIGNAL(lane, rdy + (126 & 3));
        asm volatile("s_waitcnt vmcnt(0)" ::: "memory"); LDS_SIGNAL(lane, rdy + (127 & 3));
#undef SC_ISSUE
    } else {
        const int ni = w;
        f32x4 S[4];
#pragma unroll
        for (int m = 0; m < 4; ++m) S[m] = (f32x4){0.f, 0.f, 0.f, 0.f};
#pragma unroll 1
        for (int chunk = 0; chunk < 128; ++chunk) {
            bf16x8 bh[2], bl[2];
#pragma unroll
            for (int ks = 0; ks < 2; ++ks) { u32x4 hw, lwv; const f32x4 s0 = S[2 * ks], s1 = S[2 * ks + 1];
                hw.x = cvtpk(s0[0], s0[1]); hw.y = cvtpk(s0[2], s0[3]); hw.z = cvtpk(s1[0], s1[1]); hw.w = cvtpk(s1[2], s1[3]);
                lwv.x = cvtpk(s0[0] - bflo(hw.x), s0[1] - bfhi(hw.x)); lwv.y = cvtpk(s0[2] - bflo(hw.y), s0[3] - bfhi(hw.y)); lwv.z = cvtpk(s1[0] - bflo(hw.z), s1[1] - bfhi(hw.z)); lwv.w = cvtpk(s1[2] - bflo(hw.w), s1[3] - bfhi(hw.w));
                bh[ks] = __builtin_bit_cast(bf16x8, hw); bl[ks] = __builtin_bit_cast(bf16x8, lwv); }
            const int sl = chunk & 3; LAS unsigned char* CBL = L + sl * SC_SLOT;
            LDS_SPIN_GE(rdy + sl, 4u * (unsigned)((chunk >> 2) + 1));
            u32x4 gt[4][2], wy[4][2]; u32x2 ht[4], y0[4];
#pragma unroll
            for (int m = 0; m < 4; ++m) {
#pragma unroll
                for (int ks = 0; ks < 2; ++ks) { const int off = ((m * 2 + ks) * 64 + lane) * 16; gt[m][ks] = *(const LAS u32x4*)(CBL + CH_GT + off); wy[m][ks] = *(const LAS u32x4*)(CBL + CH_WY + off); }
                ht[m] = *(const LAS u32x2*)(CBL + CH_HT + ((m * 4 + ni) * 64 + lane) * 8); y0[m] = *(const LAS u32x2*)(CBL + CH_Y0 + ((m * 4 + ni) * 64 + lane) * 8); }
            LDS_SIGNAL(lane, dne + sl);
            const size_t tokb = (size_t)b * SEQ + 64 * chunk;
#pragma unroll
            for (int m = 0; m < 4; ++m) {
                f32x4 ns = (f32x4){bflo(ht[m].x), bfhi(ht[m].x), bflo(ht[m].y), bfhi(ht[m].y)};
                f32x4 y = (f32x4){bflo(y0[m].x), bfhi(y0[m].x), bflo(y0[m].y), bfhi(y0[m].y)};
#pragma unroll
                for (int ks = 0; ks < 2; ++ks) { const bf16x8 ag = __builtin_bit_cast(bf16x8, gt[m][ks]); const bf16x8 aw = __builtin_bit_cast(bf16x8, wy[m][ks]);
                    ns = MF16(ag, bh[ks], ns); ns = MF16(ag, bl[ks], ns); y = MF16(aw, bh[ks], y); y = MF16(aw, bl[ks], y); }
                bf16_t* yp = ((bf16_t*)(F.wsb + WS_AA)) + (tokb + 16 * m + 4 * g) * 512 + h * 64 + 16 * ni + c;
#pragma unroll
                for (int r = 0; r < 4; ++r) yp[(size_t)r * 512] = f2bf(y[r]);
                S[m] = ns;
            }
        }
    }
    asm volatile("s_waitcnt vmcnt(0)" ::: "memory");
    __syncthreads();
    if (F.tid == 0) { __builtin_amdgcn_fence(__ATOMIC_RELEASE, "agent"); asm volatile("s_waitcnt vmcnt(0)" ::: "memory"); (void)__hip_atomic_fetch_add(F.ctl + CW_SCAN_DONE, 1u, RLX_AGENT); }
}

__device__ __forceinline__ void rwkv_post(Frame& F0) {
    PHASE_FRAME(F, F0);
    const int lane = F.lane, c0 = lane * 8;
    bf16_t* OAB = ((bf16_t*)(F.wsb + WS_XN));
    LAS int* slot = (LAS int*)(F.lds + LDS_BYTES - 256) + 8;
    __syncthreads();
    if (F.tid == 0) {
        unsigned sp = 0u;
        while (__hip_atomic_load(F.ctl + CW_SCAN_DONE, __ATOMIC_RELAXED, __HIP_MEMORY_SCOPE_AGENT) < 32u) { __builtin_amdgcn_s_sleep(8); if (++sp > (1u << 24)) break; }
        __builtin_amdgcn_fence(__ATOMIC_ACQUIRE, "agent");
        slot[0] = (int)__hip_atomic_fetch_add(F.ctl + CW_Q_POST, 1u, RLX_AGENT);
    }
    __syncthreads();
    int par = 0;
    for (;;) {
        const int item = __builtin_amdgcn_readfirstlane(slot[par]);
        if (item >= 512) break;
        int nxt = 0; if (F.tid == 0) nxt = (int)__hip_atomic_fetch_add(F.ctl + CW_Q_POST, 1u, RLX_AGENT);
    for (int k2 = 0; k2 < 2; ++k2) { const int it = item * 16 + k2 * 8 + F.wave;
        const int t0 = it * 4;
        float muv[8], lw_[8], lb_[8];
#pragma unroll
        for (int e = 0; e < 8; ++e) { muv[e] = F.A.in[(I_MUV) + F.z][c0 + e]; lw_[e] = F.A.in[(I_LNXW) + F.z][c0 + e]; lb_[e] = F.A.in[(I_LNXB) + F.z][c0 + e]; }
#pragma unroll
        for (int q = 0; q < 4; ++q) { const int t = t0 + q; const bool hp = (t & (SEQ - 1)) != 0; const size_t zr = (size_t)t * ZP, zq = (size_t)(t - 1) * ZP;
            const u32x4 yw = *(const u32x4*)(((bf16_t*)(F.wsb + WS_AA)) + (size_t)t * 512 + c0);
            const u32x4 gw4 = *(const u32x4*)(OAB + (size_t)t * 1024 + 512 + c0);
            const u32x4 vz = *(const u32x4*)(((bf16_t*)(F.wsb + WS_ZA)) + zr + C_V + c0);
            u32x4 vp = (u32x4){0u, 0u, 0u, 0u}; if (hp) vp = *(const u32x4*)(((bf16_t*)(F.wsb + WS_ZA)) + zq + C_V + c0);
            const float bs = ((float*)(F.wsb + WS_BON))[(size_t)t * 8 + (lane >> 3)];
            float y[8], vs[8]; float sy = 0.f;
#pragma unroll
            for (int e = 0; e < 8; ++e) {
#define UNP(W) ((e & 1) ? bfhi(W[e >> 1]) : bflo(W[e >> 1]))
                y[e] = UNP(yw); sy += y[e]; const float v0 = UNP(vz), v1 = UNP(vp);
#undef UNP
                vs[e] = v0 + (v1 - v0) * muv[e]; }
            sy += __shfl_xor(sy, 1); sy += __shfl_xor(sy, 2); sy += __shfl_xor(sy, 4);
            const float mean = sy * (1.f / 64.f); float sv = 0.f;
#pragma unroll
            for (int e = 0; e < 8; ++e) { const float d = y[e] - mean; sv += d * d; }
            sv += __shfl_xor(sv, 1); sv += __shfl_xor(sv, 2); sv += __shfl_xor(sv, 4);
            const float rstd = __builtin_amdgcn_rsqf(sv * (1.f / 64.f) + 64e-5f); float o[8];
#pragma unroll
            for (int e = 0; e < 8; ++e) { const unsigned gwv = gw4[e >> 1]; o[e] = (((y[e] - mean) * rstd) * lw_[e] + lb_[e] + bs * vs[e]) * ((e & 1) ? bfhi(gwv) : bflo(gwv)); }
            *(u32x4*)(OAB + (size_t)t * 1024 + 512 + c0) = (u32x4){cvtpk(o[0], o[1]), cvtpk(o[2], o[3]), cvtpk(o[4], o[5]), cvtpk(o[6], o[7])};
        }
    }
        if (F.tid == 0) slot[par ^ 1] = nxt;
        __syncthreads();
        par ^= 1;
    }
}

struct AttnSt { float m, l; f32x4 o[4]; };
__device__ __forceinline__ void attn_init(AttnSt& s) { s.m = -1e30f; s.l = 0.f;
#pragma unroll
    for (int d = 0; d < 4; ++d) s.o[d] = (f32x4){0.f, 0.f, 0.f, 0.f}; }
__device__ __forceinline__ void qk_block(f32x4 (&s)[4], const bf16x8 q0, const bf16x8 q1, const bf16_t* Kb, int kp, int c, int g) {
#pragma unroll
    for (int kt = 0; kt < 4; ++kt) { const bf16_t* kr = Kb + (size_t)(16 * kt + c) * kp + 8 * g;
        const bf16x8 k0 = *(const bf16x8*)kr, k1 = *(const bf16x8*)(kr + 32);
        f32x4 z = (f32x4){0.f, 0.f, 0.f, 0.f};
        z = __builtin_amdgcn_mfma_f32_16x16x32_bf16(k0, q0, z, 0, 0, 0); s[kt] = __builtin_amdgcn_mfma_f32_16x16x32_bf16(k1, q1, z, 0, 0, 0); }
}
__device__ __forceinline__ void pv_block(f32x4 (&o)[4], const f32x4 (&p)[4], const bf16_t* VTb, int vtp, int c, int g) {
#pragma unroll
    for (int ks = 0; ks < 2; ++ks) {
        u32x4 pw; pw.x = cvtpk(p[2 * ks][0], p[2 * ks][1]); pw.y = cvtpk(p[2 * ks][2], p[2 * ks][3]); pw.z = cvtpk(p[2 * ks + 1][0], p[2 * ks + 1][1]); pw.w = cvtpk(p[2 * ks + 1][2], p[2 * ks + 1][3]);
        const bf16x8 pb = __builtin_bit_cast(bf16x8, pw);
#pragma unroll
        for (int dt = 0; dt < 4; ++dt) { const bf16_t* vr = VTb + (size_t)(16 * dt + c) * vtp + 32 * ks + 4 * g;
            const u32x2 va = *(const u32x2*)vr, vb = *(const u32x2*)(vr + 16);
            const bf16x8 a = __builtin_bit_cast(bf16x8, (u32x4){va.x, va.y, vb.x, vb.y});
            o[dt] = __builtin_amdgcn_mfma_f32_16x16x32_bf16(a, pb, o[dt], 0, 0, 0); }
    }
}
template <class Valid>
__device__ __forceinline__ void attn_block(AttnSt& st, const bf16x8 q0, const bf16x8 q1, const bf16_t* Kb, int kp, const bf16_t* VTb, int vtp, int c, int g, const Valid& valid) {
    f32x4 s[4]; qk_block(s, q0, q1, Kb, kp, c, g);
    float mx = -1e30f;
#pragma unroll
    for (int kt = 0; kt < 4; ++kt)
#pragma unroll
        for (int r = 0; r < 4; ++r) { const bool v = valid(16 * kt + 4 * g + r); s[kt][r] = v ? s[kt][r] : -1e30f; mx = fmaxf(mx, s[kt][r]); }
    mx = fmaxf(mx, __shfl_xor(mx, 16)); mx = fmaxf(mx, __shfl_xor(mx, 32));
    const float mn = fmaxf(st.m, mx), alpha = fast_exp2(st.m - mn); float ps = 0.f;
#pragma unroll
    for (int kt = 0; kt < 4; ++kt)
#pragma unroll
        for (int r = 0; r < 4; ++r) { const float p = (s[kt][r] > -1e29f) ? fast_exp2(s[kt][r] - mn) : 0.f; s[kt][r] = p; ps += p; }
    st.l = st.l * alpha + ps; st.m = mn;
#pragma unroll
    for (int d = 0; d < 4; ++d) st.o[d] = st.o[d] * alpha;
    pv_block(st.o, s, VTb, vtp, c, g);
}

constexpr int NSLOT = 8192, NK_OFF = 0, NV_OFF = 2 * NSLOT, NI_OFF = 4 * NSLOT, NACC_OFF = NI_OFF + 65536, NQ_OFF = LDS_BYTES - 256;

__device__ __forceinline__ void qk_block_lds(f32x4 (&s)[4], const bf16x8 q0, const bf16x8 q1, LAS unsigned char* Kb, int c, int g) {
#pragma unroll
    for (int kt = 0; kt < 4; ++kt) {
        const bf16x8 k0 = *(const LAS bf16x8*)(Kb + nsa_off(16 * kt + c, g)), k1 = *(const LAS bf16x8*)(Kb + nsa_off(16 * kt + c, 4 + g));
        f32x4 z = (f32x4){0.f, 0.f, 0.f, 0.f};
        z = __builtin_amdgcn_mfma_f32_16x16x32_bf16(k0, q0, z, 0, 0, 0); s[kt] = __builtin_amdgcn_mfma_f32_16x16x32_bf16(k1, q1, z, 0, 0, 0); }
}
__device__ __forceinline__ void pv_block_lds(f32x4 (&o)[4], const f32x4 (&p)[4], LAS unsigned char* Vb, int c, int g) {
#pragma unroll
    for (int ks = 0; ks < 2; ++ks) {
        u32x4 pw; pw.x = cvtpk(p[2 * ks][0], p[2 * ks][1]); pw.y = cvtpk(p[2 * ks][2], p[2 * ks][3]); pw.z = cvtpk(p[2 * ks + 1][0], p[2 * ks + 1][1]); pw.w = cvtpk(p[2 * ks + 1][2], p[2 * ks + 1][3]);
        const bf16x8 pb = __builtin_bit_cast(bf16x8, pw);
#pragma unroll
        for (int dt = 0; dt < 4; ++dt) { const bf16x8 a = *(const LAS bf16x8*)(Vb + nsa_off(16 * dt + c, 4 * ks + g));
            o[dt] = __builtin_amdgcn_mfma_f32_16x16x32_bf16(a, pb, o[dt], 0, 0, 0); }
    }
}
__device__ __forceinline__ int fbits(float x) { return __builtin_bit_cast(int, x); }
template <bool SAFE, bool MASKED, bool PV, class VA_, class VB_>
__device__ __forceinline__ void attn_block2g(AttnSt& sA, AttnSt& sB, const bf16x8 qa0, const bf16x8 qa1, const bf16x8 qb0, const bf16x8 qb1, LAS unsigned char* Kb, LAS unsigned char* Vb, int c, int g,
                                             bool needA, bool needB, bool doA, bool doB, const VA_& validA, const VB_& validB) {
    f32x4 sa[4], sb[4]; const float nma = needA ? (SAFE ? -sA.m : 0.f) : -1e30f, nmb = needB ? (SAFE ? -sB.m : 0.f) : -1e30f; const f32x4 cia = (f32x4){nma, nma, nma, nma}, cib = (f32x4){nmb, nmb, nmb, nmb};
#pragma unroll
    for (int kt = 0; kt < 4; ++kt) {
        const bf16x8 k0 = *(const LAS bf16x8*)(Kb + nsa_off(16 * kt + c, g)), k1 = *(const LAS bf16x8*)(Kb + nsa_off(16 * kt + c, 4 + g));
        sa[kt] = __builtin_amdgcn_mfma_f32_16x16x32_bf16(k0, qa0, cia, 0, 0, 0); sb[kt] = __builtin_amdgcn_mfma_f32_16x16x32_bf16(k0, qb0, cib, 0, 0, 0);
        sa[kt] = __builtin_amdgcn_mfma_f32_16x16x32_bf16(k1, qa1, sa[kt], 0, 0, 0); sb[kt] = __builtin_amdgcn_mfma_f32_16x16x32_bf16(k1, qb1, sb[kt], 0, 0, 0); }
    if (MASKED) {
#pragma unroll
        for (int kt = 0; kt < 4; ++kt)
#pragma unroll
            for (int r = 0; r < 4; ++r) { sa[kt][r] = validA(16 * kt + 4 * g + r) ? sa[kt][r] : -1e30f; sb[kt][r] = validB(16 * kt + 4 * g + r) ? sb[kt][r] : -1e30f; }
    }
if (SAFE) {
#define IB_(x) fbits(x)
    int ima = max(max(IB_(sa[0][0]), IB_(sa[0][1])), max(IB_(sa[0][2]), IB_(sa[0][3]))), imb = max(max(IB_(sb[0][0]), IB_(sb[0][1])), max(IB_(sb[0][2]), IB_(sb[0][3])));
#pragma unroll
    for (int kt = 1; kt < 4; ++kt) { ima = max(ima, max(max(IB_(sa[kt][0]), IB_(sa[kt][1])), max(IB_(sa[kt][2]), IB_(sa[kt][3])))); imb = max(imb, max(max(IB_(sb[kt][0]), IB_(sb[kt][1])), max(IB_(sb[kt][2]), IB_(sb[kt][3])))); }
#undef IB_
    if (__builtin_expect(__ballot((ima > 0x41000000) || (imb > 0x41000000)) != 0ull, 0)) {
        float mxa = (ima > 0x41000000) ? __builtin_bit_cast(float, ima) : 0.f, mxb = (imb > 0x41000000) ? __builtin_bit_cast(float, imb) : 0.f;
        mxa = fmaxf(mxa, __shfl_xor(mxa, 16)); mxa = fmaxf(mxa, __shfl_xor(mxa, 32)); mxb = fmaxf(mxb, __shfl_xor(mxb, 16)); mxb = fmaxf(mxb, __shfl_xor(mxb, 32));
        const float da = (mxa > 8.0f) ? mxa : 0.f, db = (mxb > 8.0f) ? mxb : 0.f; const float ala = fast_exp2(-da), alb = fast_exp2(-db);
        sA.m += da; sA.l *= ala; sB.m += db; sB.l *= alb;
#pragma unroll
        for (int kt = 0; kt < 4; ++kt) { sa[kt] = sa[kt] - da; sb[kt] = sb[kt] - db; }
        if (PV) {
#pragma unroll
            for (int dd = 0; dd < 4; ++dd) { sA.o[dd] = sA.o[dd] * ala; sB.o[dd] = sB.o[dd] * alb; } }
    }
    }
    float psa = 0.f, psb = 0.f;
#pragma unroll
    for (int kt = 0; kt < 4; ++kt)
#pragma unroll
        for (int r = 0; r < 4; ++r) { sa[kt][r] = fast_exp2(sa[kt][r]); psa += sa[kt][r]; sb[kt][r] = fast_exp2(sb[kt][r]); psb += sb[kt][r]; }
    sA.l += psa; sB.l += psb;
    if (PV) {
#pragma unroll
        for (int ks = 0; ks < 2; ++ks) {
            u32x4 pa, pb2; pa.x = cvtpk(sa[2 * ks][0], sa[2 * ks][1]); pa.y = cvtpk(sa[2 * ks][2], sa[2 * ks][3]); pa.z = cvtpk(sa[2 * ks + 1][0], sa[2 * ks + 1][1]); pa.w = cvtpk(sa[2 * ks + 1][2], sa[2 * ks + 1][3]);
            pb2.x = cvtpk(sb[2 * ks][0], sb[2 * ks][1]); pb2.y = cvtpk(sb[2 * ks][2], sb[2 * ks][3]); pb2.z = cvtpk(sb[2 * ks + 1][0], sb[2 * ks + 1][1]); pb2.w = cvtpk(sb[2 * ks + 1][2], sb[2 * ks + 1][3]);
            const bf16x8 fa = __builtin_bit_cast(bf16x8, pa), fb = __builtin_bit_cast(bf16x8, pb2);
#pragma unroll
            for (int dt = 0; dt < 4; ++dt) { const bf16x8 a = *(const LAS bf16x8*)(Vb + nsa_off(16 * dt + c, 4 * ks + g));
                sA.o[dt] = __builtin_amdgcn_mfma_f32_16x16x32_bf16(a, fa, sA.o[dt], 0, 0, 0);
                sB.o[dt] = __builtin_amdgcn_mfma_f32_16x16x32_bf16(a, fb, sB.o[dt], 0, 0, 0); }
        }
    }
}
#define NSA_BLOCK_LOOP(F, Kg_, kp_, Vg_, vp_, hasV_, lo_, hi_, ...) do { \
    const int kb_lo_ = (lo_), kb_hi_ = (hi_); const bool hasV__ = (hasV_); \
    if (kb_hi_ >= kb_lo_) { \
    LAS unsigned char* L_ = F.lds; const int row_ = F.tid >> 3, ch_ = F.tid & 7; const int koff_ = nsa_off(row_, ch_); \
    const size_t kpp_ = (kp_), vpp_ = (vp_); const size_t vbs_ = (vpp_ == 64) ? 4096 : 64;        \
    const GAS bf16_t* kpt_ = (const GAS bf16_t*)(Kg_) + ((size_t)64 * kb_lo_ + row_) * kpp_ + 8 * ch_; const GAS bf16_t* vpt_ = (const GAS bf16_t*)(Vg_) + (size_t)row_ * vpp_ + vbs_ * kb_lo_ + 8 * ch_; const size_t kst_ = 64 * kpp_; \
    u32x4 k0r_, v0r_ = (u32x4){0u, 0u, 0u, 0u}, k1r_ = (u32x4){0u, 0u, 0u, 0u}, v1r_ = (u32x4){0u, 0u, 0u, 0u}; \
    NSA_BL_LOAD(k0r_, v0r_, kb_lo_); if (kb_lo_ + 1 <= kb_hi_) NSA_BL_LOAD(k1r_, v1r_, kb_lo_ + 1); \
    NSA_BL_WRITE(k0r_, v0r_, 0); \
    LDS_BAR(); \
    for (int kb_ = kb_lo_; kb_ <= kb_hi_; kb_ += 2) { \
        if (kb_ + 2 <= kb_hi_) NSA_BL_LOAD(k0r_, v0r_, kb_ + 2); \
        { const int kb = kb_; LAS unsigned char* Kb = L_ + NK_OFF; LAS unsigned char* Vb = L_ + NV_OFF; __VA_ARGS__ } \
        if (kb_ + 1 <= kb_hi_) NSA_BL_WRITE(k1r_, v1r_, 1); \
        LDS_BAR(); \
        if (kb_ + 1 > kb_hi_) break; \
        if (kb_ + 3 <= kb_hi_) NSA_BL_LOAD(k1r_, v1r_, kb_ + 3); \
        { const int kb = kb_ + 1; LAS unsigned char* Kb = L_ + NK_OFF + NSLOT; LAS unsigned char* Vb = L_ + NV_OFF + NSLOT; __VA_ARGS__ } \
        if (kb_ + 2 <= kb_hi_) NSA_BL_WRITE(k0r_, v0r_, 0); \
        LDS_BAR(); \
    } } } while (0)
#define NSA_BL_LOAD(KR, VR, KB) do { KR = *(const GAS u32x4*)(kpt_ + (size_t)((KB) - kb_lo_) * kst_); if (hasV__) VR = *(const GAS u32x4*)(vpt_ + vbs_ * (size_t)((KB) - kb_lo_)); } while (0)
#define NSA_BL_WRITE(KR, VR, BS) do { *(LAS u32x4*)(L_ + NK_OFF + (BS) * NSLOT + koff_) = KR; if (hasV__) *(LAS u32x4*)(L_ + NV_OFF + (BS) * NSLOT + koff_) = VR; } while (0)
__device__ __forceinline__ void nsa_topk(LAS float* IA, LAS float* IB, int cur, int lane, int qi, unsigned& mk0, unsigned& mk1, unsigned& mk2, unsigned& mk3) {
    const int tqi = lane >> 4, sub = lane & 15; unsigned key[8];
#pragma unroll
    for (int e = 0; e < 8; ++e) { const int j = sub * 8 + e; const float v = IA[tqi * 128 + j] + ((j >= 1) ? IB[tqi * 128 + j - 1] : 0.f);
        const bool ok = (j >= 1) && (j <= cur - 1); key[e] = ok ? ((__builtin_bit_cast(unsigned, v) & ~127u) | (unsigned)(127 - j)) : 0u; }
    unsigned s0 = 0u, s1 = 0u, s2 = 0u, s3 = 0u;
    for (int rnd = 0; rnd < 14; ++rnd) {
        unsigned lm = key[0];
#pragma unroll
        for (int e = 1; e < 8; ++e) lm = lm > key[e] ? lm : key[e];
        unsigned gm = lm;
#pragma unroll
        for (int o = 1; o < 16; o <<= 1) { const unsigned x = (unsigned)__shfl_xor((int)gm, o); gm = gm > x ? gm : x; }
#pragma unroll
        for (int e = 0; e < 8; ++e) key[e] = (key[e] == gm) ? 0u : key[e];
        const int js = 127 - (int)(gm & 127u); const unsigned bit = 1u << (js & 31);
        if (gm != 0u) { if (js < 32) s0 |= bit; else if (js < 64) s1 |= bit; else if (js < 96) s2 |= bit; else s3 |= bit; }
    }
    s0 |= 1u; { const unsigned bit = 1u << (cur & 31); if (cur < 32) s0 |= bit; else if (cur < 64) s1 |= bit; else if (cur < 96) s2 |= bit; else s3 |= bit; }
    const int src = 16 * qi;
    mk0 = (unsigned)__shfl((int)s0, src); mk1 = (unsigned)__shfl((int)s1, src); mk2 = (unsigned)__shfl((int)s2, src); mk3 = (unsigned)__shfl((int)s3, src);
}
template <bool SAFE>
__device__ __forceinline__ bool nsa_item_wg(Frame& F1, int item) {
    Frame F = F1; asm volatile("" : "+v"(F.tid), "+v"(F.lane));
    const int lane = F.lane, w = F.wave, c = lane & 15, g = lane >> 4, qi = c >> 2, hh = c & 3;
    const int bg = item & 7, b = bg >> 1, g2 = bg & 1, t0w = (127 - (item >> 3)) * 64, t0 = t0w + 8 * w, tqa = t0 + qi, tqb = t0 + 4 + qi, cur = t0w >> 6;
    const size_t toka = (size_t)b * SEQ + tqa, tokb = toka + 4;
    LAS float* wscr = (LAS float*)(F.lds + NI_OFF + w * 8192); LAS float* IA = wscr; LAS float* IB = wscr + 1024;
    const bf16_t* ZAp = (bf16_t*)(F.wsb + WS_ZA);
    AttnSt sa, sb; bool bad = false;
    const bf16_t* nga = ZAp + toka * ZP + C_NG + g2 * 4 + hh; const bf16_t* ngb = ZAp + tokb * ZP + C_NG + g2 * 4 + hh;
    bf16_t* opa = ((bf16_t*)(F.wsb + WS_XN)) + toka * 1024 + (4 * g2 + hh) * 64 + 4 * g; bf16_t* opb = opa + 4 * 1024;
    LAS unsigned char* accp = F.lds + NACC_OFF + w * 4096 + lane * 8;
#define NSA_FLUSH(MODE, GA, GB) do { _Pragma("unroll") for (int dt = 0; dt < 4; ++dt) { f32x4 o1 = sa.o[dt] * (GA), o2 = sb.o[dt] * (GB); \
        if ((MODE) != 0) { const u32x2 p1 = *(const LAS u32x2*)(accp + (2 * dt) * 512), p2 = *(const LAS u32x2*)(accp + (2 * dt + 1) * 512); o1 = o1 + (f32x4){bflo(p1.x), bfhi(p1.x), bflo(p1.y), bfhi(p1.y)}; o2 = o2 + (f32x4){bflo(p2.x), bfhi(p2.x), bflo(p2.y), bfhi(p2.y)}; } \
        u32x2 w1; w1.x = cvtpk(o1[0], o1[1]); w1.y = cvtpk(o1[2], o1[3]); u32x2 w2; w2.x = cvtpk(o2[0], o2[1]); w2.y = cvtpk(o2[2], o2[3]); \
        if ((MODE) == 2) { *(u32x2*)(opa + 16 * dt) = w1; *(u32x2*)(opb + 16 * dt) = w2; } else { *(LAS u32x2*)(accp + (2 * dt) * 512) = w1; *(LAS u32x2*)(accp + (2 * dt + 1) * 512) = w2; } } } while (0)
    {
        attn_init(sa); sa.m = 0.f; attn_init(sb); sb.m = 0.f;
_Pragma("unroll")
        for (int e = 0; e < 32; ++e) wscr[e * 64 + lane] = 0.f;
        const bf16_t* qpa = ZAp + toka * ZP + (4 * g2 + hh) * 64 + 8 * g; const bf16_t* qpb = ZAp + tokb * ZP + (4 * g2 + hh) * 64 + 8 * g;
        const bf16x8 qa0 = *(const bf16x8*)qpa, qa1 = *(const bf16x8*)(qpa + 32), qb0 = *(const bf16x8*)qpb, qb1 = *(const bf16x8*)(qpb + 32);
        const int nmaxa = (tqa >= 31) ? ((tqa - 31) >> 4) : -1, nmaxb = (tqb >= 31) ? ((tqb - 31) >> 4) : -1, nkb = (((t0w + 32) >> 4) >> 6) + 1;
        const int nmin = (t0 >= 31) ? ((t0 - 31) >> 4) : -1;
        const bf16_t* KCb = ((bf16_t*)(F.wsb + WS_KC)) + (size_t)bg * 512 * 64; const bf16_t* VCTb = ((bf16_t*)(F.wsb + WS_VCT)) + (size_t)bg * 64 * 512;
        NSA_BLOCK_LOOP(F, KCb, 64, VCTb, 512, false, 0, nkb - 1, {
            if (64 * kb + 63 <= nmin) attn_block2g<SAFE, false, false>(sa, sb, qa0, qa1, qb0, qb1, Kb, Vb, c, g, true, true, true, true, [=](int off) { return true; }, [=](int off) { return true; });
            else attn_block2g<SAFE, true, false>(sa, sb, qa0, qa1, qb0, qb1, Kb, Vb, c, g, true, true, true, true, [=](int off) { return (64 * kb + off) <= nmaxa; }, [=](int off) { return (64 * kb + off) <= nmaxb; }); });
        float l1a = sa.l; l1a += __shfl_xor(l1a, 16); l1a += __shfl_xor(l1a, 32); float l1b = sb.l; l1b += __shfl_xor(l1b, 16); l1b += __shfl_xor(l1b, 32);
        if (!SAFE) bad = bad || !(l1a < 1e30f) || !(l1b < 1e30f);
        const float ila = (l1a > 0.f) ? 1.0f / l1a : 0.f, ilb = (l1b > 0.f) ? 1.0f / l1b : 0.f; const float m1a = sa.m, m1b = sb.m;
        NSA_BLOCK_LOOP(F, KCb, 64, VCTb, 512, true, 0, nkb - 1, {
            f32x4 pa[4], pb[4];
_Pragma("unroll")
            for (int kt = 0; kt < 4; ++kt) { const bf16x8 k0 = *(const LAS bf16x8*)(Kb + nsa_off(16 * kt + c, g)), k1 = *(const LAS bf16x8*)(Kb + nsa_off(16 * kt + c, 4 + g)); const f32x4 z = (f32x4){0.f, 0.f, 0.f, 0.f};
                pa[kt] = __builtin_amdgcn_mfma_f32_16x16x32_bf16(k0, qa0, z, 0, 0, 0); pb[kt] = __builtin_amdgcn_mfma_f32_16x16x32_bf16(k0, qb0, z, 0, 0, 0);
                pa[kt] = __builtin_amdgcn_mfma_f32_16x16x32_bf16(k1, qa1, pa[kt], 0, 0, 0); pb[kt] = __builtin_amdgcn_mfma_f32_16x16x32_bf16(k1, qb1, pb[kt], 0, 0, 0); }
_Pragma("unroll")
            for (int kt = 0; kt < 4; ++kt) {
_Pragma("unroll")
                for (int r = 0; r < 4; ++r) { const int n = 64 * kb + 16 * kt + 4 * g + r; pa[kt][r] = (n <= nmaxa) ? fast_exp2(pa[kt][r] - m1a) * ila : 0.f; pb[kt][r] = (n <= nmaxb) ? fast_exp2(pb[kt][r] - m1b) * ilb : 0.f; }
                float s4a = (pa[kt][0] + pa[kt][1]) + (pa[kt][2] + pa[kt][3]), p3a = pa[kt][3], s4b = (pb[kt][0] + pb[kt][1]) + (pb[kt][2] + pb[kt][3]), p3b = pb[kt][3];
                s4a += __shfl_xor(s4a, 1); s4a += __shfl_xor(s4a, 2); p3a += __shfl_xor(p3a, 1); p3a += __shfl_xor(p3a, 2);
                s4b += __shfl_xor(s4b, 1); s4b += __shfl_xor(s4b, 2); p3b += __shfl_xor(p3b, 1); p3b += __shfl_xor(p3b, 2);
                if (hh == 0) { const int j = 16 * kb + 4 * kt + g; IA[qi * 128 + j] = s4a; IB[qi * 128 + j] = p3a; IA[(4 + qi) * 128 + j] = s4b; IB[(4 + qi) * 128 + j] = p3b; } }
            pv_block_lds(sa.o, pa, Vb, c, g); pv_block_lds(sb.o, pb, Vb, c, g); });
        const float gca = sigmoidf_(bf2f(nga[0])), gcb = sigmoidf_(bf2f(ngb[0]));
        NSA_FLUSH(0, gca, gcb);
    }
    LDS_WAIT(); asm volatile("" ::: "memory");
    unsigned ma0 = 0u, ma1 = 0u, ma2 = 0u, ma3 = 0u, mb0 = 0u, mb1 = 0u, mb2 = 0u, mb3 = 0u;
    if (cur <= 15) { ma0 = (1u << (cur + 1)) - 1u; mb0 = ma0; }
    else { nsa_topk(IA, IB, cur, lane, qi, ma0, ma1, ma2, ma3); nsa_topk(IA + 512, IB + 512, cur, lane, qi, mb0, mb1, mb2, mb3); }
    const bf16_t* qpa = ((bf16_t*)(F.wsb + WS_QR)) + toka * 512 + (4 * g2 + hh) * 64 + 8 * g; const bf16_t* qpb = qpa + 4 * 512;
    const bf16x8 qa0 = *(const bf16x8*)qpa, qa1 = *(const bf16x8*)(qpa + 32), qb0 = *(const bf16x8*)qpb, qb1 = *(const bf16x8*)(qpb + 32);
    {
        attn_init(sa); sa.m = 0.f; attn_init(sb); sb.m = 0.f;
        NSA_BLOCK_LOOP(F, ((bf16_t*)(F.wsb + WS_KSB)) + (size_t)bg * SEQ * 64, 64, ((bf16_t*)(F.wsb + WS_VST)) + (size_t)bg * 64 * SEQ, 64, true, 0, cur, {
            const unsigned wa = kb < 32 ? ma0 : kb < 64 ? ma1 : kb < 96 ? ma2 : ma3, wb = kb < 32 ? mb0 : kb < 64 ? mb1 : kb < 96 ? mb2 : mb3;
            const bool needA = (wa >> (kb & 31)) & 1u, needB = (wb >> (kb & 31)) & 1u; const bool doA = __ballot(needA) != 0ull, doB = __ballot(needB) != 0ull;
            if (doA || doB) { const int lima = tqa - 64 * kb, limb = tqb - 64 * kb;
                if (kb < cur) attn_block2g<SAFE, false, true>(sa, sb, qa0, qa1, qb0, qb1, Kb, Vb, c, g, needA, needB, doA, doB, [=](int off) { return true; }, [=](int off) { return true; });
                else attn_block2g<SAFE, true, true>(sa, sb, qa0, qa1, qb0, qb1, Kb, Vb, c, g, needA, needB, doA, doB, [=](int off) { return off <= lima; }, [=](int off) { return off <= limb; }); } });
        float la = sa.l; la += __shfl_xor(la, 16); la += __shfl_xor(la, 32); float lb = sb.l; lb += __shfl_xor(lb, 16); lb += __shfl_xor(lb, 32);
        if (!SAFE) bad = bad || !(la < 1e30f) || !(lb < 1e30f);
        const float gsa = (la > 0.f) ? sigmoidf_(bf2f(nga[8])) / la : 0.f, gsb = (lb > 0.f) ? sigmoidf_(bf2f(ngb[8])) / lb : 0.f;
        NSA_FLUSH(1, gsa, gsb);
    }
    {
        attn_init(sa); sa.m = 0.f; attn_init(sb); sb.m = 0.f;
        NSA_BLOCK_LOOP(F, ((bf16_t*)(F.wsb + WS_KWB)) + (size_t)bg * SEQ * 64, 64, ((bf16_t*)(F.wsb + WS_VWT)) + (size_t)bg * 64 * SEQ, 64, true, (cur >= 8) ? cur - 8 : 0, cur, {
            const int lima = tqa - 64 * kb, limb = tqb - 64 * kb, lim0 = t0 - 64 * kb;
            if (lim0 + 7 >= 0 && lim0 - 512 < 63) {
                if (lim0 >= 63 && lim0 + 7 - 512 < 0) attn_block2g<SAFE, false, true>(sa, sb, qa0, qa1, qb0, qb1, Kb, Vb, c, g, true, true, true, true, [=](int off) { return true; }, [=](int off) { return true; });
                else attn_block2g<SAFE, true, true>(sa, sb, qa0, qa1, qb0, qb1, Kb, Vb, c, g, true, true, true, true, [=](int off) { return (off <= lima) && (off > lima - 512); }, [=](int off) { return (off <= limb) && (off > limb - 512); }); } });
        float la = sa.l; la += __shfl_xor(la, 16); la += __shfl_xor(la, 32); float lb = sb.l; lb += __shfl_xor(lb, 16); lb += __shfl_xor(lb, 32);
        if (!SAFE) bad = bad || !(la < 1e30f) || !(lb < 1e30f);
        const float gwa = (la > 0.f) ? sigmoidf_(bf2f(nga[16])) / la : 0.f, gwb = (lb > 0.f) ? sigmoidf_(bf2f(ngb[16])) / lb : 0.f;
        NSA_FLUSH(2, gwa, gwb);
    }
    return __ballot(bad) != 0ull;
}
#undef NSA_FLUSH
__device__ __forceinline__ void nsa_phase(Frame& F0) {
    PHASE_FRAME(F, F0);
    LAS int* slot = (LAS int*)(F.lds + NQ_OFF); const int myq = (int)(xb_xcc_id() & 7u);
    __syncthreads();
    for (int qq = 0; qq < 8; ++qq) {
        const int q = (myq + qq) & 7; unsigned* head = F.ctl + CW_Q_NSA + 64 * q;
        for (;;) {
            if (F.tid == 0) { *slot = (int)__hip_atomic_fetch_add(head, 1u, RLX_AGENT); slot[1] = 0; }
            __syncthreads();
            const int idx = __builtin_amdgcn_readfirstlane(*slot);
            __syncthreads();
            if (idx >= 128) break;
            const bool bad = nsa_item_wg<false>(F, (idx << 3) | q);
            if (bad && F.lane == 0) slot[1] = 1;
            __syncthreads();
            const int redo = __builtin_amdgcn_readfirstlane(slot[1]);
            __syncthreads();
            if (redo) nsa_item_wg<true>(F, (idx << 3) | q);
        }
    }
}

__device__ __forceinline__ void row_pass1(Frame& F0, const bf16_t* MIX, bf16_t* H2, bf16_t* X1B) {
    PHASE_FRAME(F, F0);
    const int lane = F.lane; f32x4 g1[4], g2[4];
#pragma unroll
    for (int j = 0; j < 4; ++j) { g1[j] = ((const f32x4*)F.A.in[(I_N1POST) + F.z])[lane + 64 * j]; g2[j] = ((const f32x4*)F.A.in[(I_N2PRE) + F.z])[lane + 64 * j]; }
    for (int m = F.gw; m < NTOK; m += F.NGW) {
        const u32x2* mr = (const u32x2*)(MIX + (size_t)m * DM) + lane; const f32x4* xr = (const f32x4*)(F.A.in[(I_X) + F.z] + (size_t)m * DM) + lane; f32x4 v[4], x[4]; float s = 0.f;
#pragma unroll
        for (int j = 0; j < 4; ++j) { const u32x2 mw = mr[64 * j]; v[j] = (f32x4){bflo(mw.x), bfhi(mw.x), bflo(mw.y), bfhi(mw.y)}; x[j] = xr[64 * j]; s += (v[j].x * v[j].x + v[j].y * v[j].y) + (v[j].z * v[j].z + v[j].w * v[j].w); }
        const float rs = 1.0f / sqrtf(wave_sum(s) * (1.f / DM) + 1e-6f); float s2 = 0.f;
        u32x2* orow = (u32x2*)(X1B + (size_t)m * DM) + lane;
#pragma unroll
        for (int j = 0; j < 4; ++j) { x[j] = x[j] + v[j] * rs * g1[j]; { u32x2 w1; w1.x = cvtpk(x[j].x, x[j].y); w1.y = cvtpk(x[j].z, x[j].w); orow[64 * j] = w1; } s2 += (x[j].x * x[j].x + x[j].y * x[j].y) + (x[j].z * x[j].z + x[j].w * x[j].w); }
        const float rs2 = 1.0f / sqrtf(wave_sum(s2) * (1.f / DM) + 1e-6f);
        u32x2* o8 = (u32x2*)(H2 + (size_t)m * DM) + lane;
#pragma unroll
        for (int j = 0; j < 4; ++j) { u32x2 w; w.x = cvtpk(x[j].x * rs2 * g2[j].x, x[j].y * rs2 * g2[j].y); w.y = cvtpk(x[j].z * rs2 * g2[j].z, x[j].w * rs2 * g2[j].w); o8[64 * j] = w; }
    }
}
__device__ __forceinline__ void row_pass2(Frame& F0, const bf16_t* Fm, const bf16_t* X1B) {
    PHASE_FRAME(F, F0);
    const int lane = F.lane; f32x4 g1[4];
#pragma unroll
    for (int j = 0; j < 4; ++j) g1[j] = ((const f32x4*)F.A.in[(I_N2POST) + F.z])[lane + 64 * j];
    for (int m = F.gw; m < NTOK; m += F.NGW) {
        const u32x2* mr = (const u32x2*)(Fm + (size_t)m * DM) + lane; f32x4* orow = (f32x4*)(F.A.out + (size_t)m * DM) + lane; const u32x2* xr = (const u32x2*)(X1B + (size_t)m * DM) + lane; f32x4 v[4], x[4]; float s = 0.f;
#pragma unroll
        for (int j = 0; j < 4; ++j) { const u32x2 mw = mr[64 * j]; v[j] = (f32x4){bflo(mw.x), bfhi(mw.x), bflo(mw.y), bfhi(mw.y)}; const u32x2 xw = xr[64 * j]; x[j] = (f32x4){bflo(xw.x), bfhi(xw.x), bflo(xw.y), bfhi(xw.y)}; s += (v[j].x * v[j].x + v[j].y * v[j].y) + (v[j].z * v[j].z + v[j].w * v[j].w); }
        const float rs = 1.0f / sqrtf(wave_sum(s) * (1.f / DM) + 1e-6f);
#pragma unroll
        for (int j = 0; j < 4; ++j) orow[64 * j] = x[j] + v[j] * rs * g1[j];
    }
}

__global__ void __launch_bounds__(NWAVES * 64, 2) hybrid_fwd(Args args) {
    extern __shared__ __attribute__((aligned(16))) unsigned char lds[];
    Frame F{args};
    F.lds = (LAS unsigned char*)lds; F.MISC = (volatile LAS unsigned*)(F.lds + MISC_OFF);
    F.tid = threadIdx.x; F.lane = F.tid & 63; F.wave = __builtin_amdgcn_readfirstlane(F.tid >> 6);
    F.G = gridDim.x; { const int bx = blockIdx.x; F.vcu = (F.G % 8 == 0) ? (bx % 8) * (F.G / 8) + bx / 8 : bx; }
    F.gw = F.vcu * NWAVES + F.wave; F.NGW = F.G * NWAVES;
    unsigned char* ws = args.ws; F.ctl = (unsigned*)(ws + WS_CTL); F.z = 0; F.wsb = (GAS unsigned char*)ws;
    for (int u = F.tid; u < (LDS_BYTES - LDSCTL_OFF) / 4; u += NWAVES * 64) ((LAS unsigned*)(F.lds + LDSCTL_OFF))[u] = 0u;
    __syncthreads();
    XcdBarrier bar = xcd_barrier_post(F.ctl + CW_BAR, F.MISC + 8);
#define GRID_BAR() xcd_barrier(bar)
    const int G = F.G, bx = (int)blockIdx.x;

    p0_prologue(F); GRID_BAR();
    { pg8::Gemm g{1024, 1024, 128u, -1}; pg8::StaticOrder S; S.init(((bf16_t*)(F.wsb + WS_XN)), ((bf16_t*)(F.wsb + WS_WIN)), NTOK, 5120, 1024, 1024, G, bx);
      EpiZ E{((bf16_t*)(F.wsb + WS_ZA)), ((bf16_t*)(F.wsb + WS_MG)), ((bf16_t*)(F.wsb + WS_QR)), ((bf16_t*)(F.wsb + WS_VST)), ((bf16_t*)(F.wsb + WS_VWT)), ((bf16_t*)(F.wsb + WS_KSB)), ((bf16_t*)(F.wsb + WS_KWB)), ((float*)(F.wsb + WS_ROPE))};
      pg8::gemm_phase(F.lds, g, S, E); GRID_BAR(); }
    { pg8::Gemm g{2048, 16 * ZP, (unsigned)(ZP * 2), -1}; CmpOrder S{F.vcu, ((bf16_t*)(F.wsb + WS_ZA)), ((bf16_t*)(F.wsb + WS_W1K)), ((bf16_t*)(F.wsb + WS_W1V))}; EpiCmp E{((bf16_t*)(F.wsb + WS_HID)), ((float*)(F.wsb + WS_B1P))};
      pg8::gemm_phase(F.lds, g, S, E);
      if (F.vcu < 32) { VM_WAIT(); __syncthreads(); cmp_stage2(F, F.vcu); } }
    rwkv_chunk_phase(F, (unsigned char*)args.out);
    GRID_BAR();
    if ((F.vcu & 31) >= 28) rwkv_scan_serial(F, (const unsigned char*)args.out, (F.vcu >> 5) * 4 + (F.vcu & 3));
    nsa_phase(F);
    rwkv_post(F);
    GRID_BAR();
    bf16_t* MIXP = (bf16_t*)(ws + WS_ZA + 128 * MiB); bf16_t* MIX = (bf16_t*)(ws + WS_ZA + 64 * MiB); bf16_t* ACT = (bf16_t*)(ws + WS_ZA); bf16_t* FM = (bf16_t*)(ws + WS_MG); bf16_t* H2 = ((bf16_t*)(F.wsb + WS_XN));
    { pg8::Gemm g{512, 1024, 128u, -1}; pg8::TwoPartOrder S; S.S.init(((bf16_t*)(F.wsb + WS_XN)), ((bf16_t*)(F.wsb + WS_WA)), NTOK, 1024, 512, 1024, G, bx); S.a2off = 1024; S.b2off = (size_t)1024 * 512 * 2; EpiMerge E{((bf16_t*)(F.wsb + WS_MG)), MIXP};
      pg8::gemm_phase(F.lds, g, S, E); GRID_BAR(); }
    { pg8::Gemm g{1024, 1024, 128u, -1}; pg8::StaticOrder S; S.init(MIXP, ((bf16_t*)(F.wsb + WS_WOUT)), NTOK, 1024, 1024, 1024, G, bx); EpiBf16Plain E{MIX, 1024};
      pg8::gemm_phase(F.lds, g, S, E); GRID_BAR(); }
    bf16_t* X1B = (bf16_t*)(ws + WS_MG + 64 * MiB);
    row_pass1(F, MIX, H2, X1B); GRID_BAR();
    { pg8::Gemm g{1024, 1024, 128u, -1}; pg8::StaticOrder S; S.init(H2, ((bf16_t*)(F.wsb + WS_WGU)), NTOK, 2 * DFF, 1024, 1024, G, bx); EpiSwiGLU E{ACT};
      pg8::gemm_phase(F.lds, g, S, E); GRID_BAR(); }
    { pg8::Gemm g{DFF, DFF, 128u, -1}; pg8::StaticOrder S; S.init(ACT, ((bf16_t*)(F.wsb + WS_WD)), NTOK, 1024, DFF, DFF, G, bx); EpiBf16Plain E{FM, 1024};
      pg8::gemm_phase(F.lds, g, S, E); GRID_BAR(); }
    row_pass2(F, FM, X1B);
}

extern "C" void kernel_launch(void* const* d_in, const int* in_sizes, int n_in, void* d_out, int out_size, void* d_ws, size_t ws_size, hipStream_t stream) {
    static int grid = 0;
    if (grid == 0) {
        if (n_in != 36 || out_size != NTOK * DM || ws_size < WS_END) { fprintf(stderr, "kernel_launch: unexpected shapes (n_in %d out %d ws %zu)\n", n_in, out_size, ws_size); grid = -1; return; }
        int dev = 0, cus = 0;
        if (hipGetDevice(&dev) != hipSuccess || hipDeviceGetAttribute(&cus, hipDeviceAttributeMultiprocessorCount, dev) != hipSuccess) { grid = -1; return; }
        if (hipFuncSetAttribute((const void*)hybrid_fwd, hipFuncAttributeMaxDynamicSharedMemorySize, LDS_BYTES) != hipSuccess) { fprintf(stderr, "kernel_launch: hipFuncSetAttribute failed\n"); grid = -1; return; }
        int per_cu = 0; (void)hipOccupancyMaxActiveBlocksPerMultiprocessor(&per_cu, (const void*)hybrid_fwd, NWAVES * 64, LDS_BYTES); (void)hipGetLastError();
        grid = cus;
        if (grid != 256) fprintf(stderr, "kernel_launch: grid %d (expected 256)\n", grid);
    }
    if (grid < 0) return;
    (void)hipMemsetAsync((char*)d_ws + WS_CTL, 0, CTL_ZERO_BYTES, stream);
    Args a{};
    for (int i = 0; i < 36; ++i) a.in[i] = (const float*)d_in[i];
    a.out = (float*)d_out; a.ws = (unsigned char*)d_ws;
    hipLaunchKernelGGL(hybrid_fwd, dim3(grid), dim3(NWAVES * 64), LDS_BYTES, stream, a);
}
```

```cpp
#include <hip/hip_runtime.h>
#include <cstdio>
#include <cstdint>

#define LAS __attribute__((address_space(3)))
#define GAS __attribute__((address_space(1)))
typedef unsigned short bf16_t;
typedef short bf16x8 __attribute__((ext_vector_type(8)));
typedef short bf16x4 __attribute__((ext_vector_type(4)));
typedef float f32x4 __attribute__((ext_vector_type(4)));
typedef float f32x2 __attribute__((ext_vector_type(2)));
typedef unsigned u32x4 __attribute__((ext_vector_type(4)));
typedef unsigned u32x2 __attribute__((ext_vector_type(2)));
typedef __bf16 bf16x2_t __attribute__((ext_vector_type(2)));

constexpr int BATCH = 4, SEQ = 8192, DM = 1024, NTOK = BATCH * SEQ;
constexpr int DFF = 2816;
constexpr int ZP = 2560;
constexpr int C_Q = 0, C_KC = 512, C_VC = 640, C_R = 768, C_K = 1280, C_V = 1792,
              C_WLO = 2304, C_ALO = 2336, C_GLO = 2368, C_NG = 2464;
constexpr float QSCALE = 0.125f * 1.4426950408889634f;
constexpr float LOG2E = 1.4426950408889634f;

__device__ __forceinline__ unsigned cvtpk(float lo, float hi) { f32x2 v = {lo, hi}; bf16x2_t b = __builtin_convertvector(v, bf16x2_t); return __builtin_bit_cast(unsigned, b); }
__device__ __forceinline__ bf16_t f2bf(float f) { return (bf16_t)(cvtpk(f, 0.f) & 0xffffu); }
__device__ __forceinline__ float bf2f(bf16_t h) { return __builtin_bit_cast(float, ((unsigned)h) << 16); }
__device__ __forceinline__ float bflo(unsigned w) { return __builtin_bit_cast(float, w << 16); }
__device__ __forceinline__ float bfhi(unsigned w) { return __builtin_bit_cast(float, w & 0xffff0000u); }
__device__ __forceinline__ float fast_exp2(float x) { return __builtin_amdgcn_exp2f(x); }
__device__ __forceinline__ float frcp(float x) { return __builtin_amdgcn_rcpf(x); }
__device__ __forceinline__ float sigmoidf_(float x) { return frcp(1.0f + __expf(-x)); }

namespace pg8 {
constexpr int BM = 256, BK = 64, HALF = 128, HTB = HALF * BK * 2, STAGE_BYTES = 8 * HTB, NXCD = 8, WGM = 8;
__host__ __device__ __forceinline__ int lds_byte(int r, int c) { const int st = (r >> 4) * 2 + (c >> 5), rr = r & 15, cc = c & 31, ob = rr * 64 + cc * 2; return st * 1024 + (ob ^ (((ob >> 9) & 1) << 5)); }
__host__ __device__ __forceinline__ void stage_rc(int b, int& R, int& C) { const int st = b / 1024, sb = b % 1024, swz = sb ^ (((sb >> 9) & 1) << 5); R = (st >> 1) * 16 + swz / 64; C = (st & 1) * 32 + (swz % 64) / 2; }
__host__ __device__ __forceinline__ int perm32(int rho) { const int n = rho >> 4, i = rho & 15; return 8 * (i >> 2) + 4 * n + (i & 3); }

struct Unit { int pm, pn; const char* a; const char* b; int part; };
struct Gemm { int K; int lda; unsigned kstepA; int unused_; };

struct StaticOrder {
    int nM, nN, nwg, G, c; const char* A; const char* Bt; size_t tstepA, tstepB;
    __device__ void init(const void* A_, const void* Bt_, int M, int N, int K, int lda, int G_, int c_) { nM = M / BM; nN = N / BM; nwg = nM * nN; G = G_; c = c_; A = (const char*)A_; Bt = (const char*)Bt_; tstepA = (size_t)BM * lda * 2; tstepB = (size_t)BM * K * 2; }
    __device__ bool next(int i, Unit& u) const {
        const long L = (long)i * G + c; if (L >= nwg) return false;
        int wgid = (int)L; { const int q = nwg / NXCD, r = nwg % NXCD, xcd = wgid % NXCD, off = wgid / NXCD; wgid = (xcd < r ? xcd * (q + 1) : r * (q + 1) + (xcd - r) * q) + off; }
        const int nig = WGM * nN, gid = wgid / nig, fm = gid * WGM, gsz = (nM - fm) < WGM ? (nM - fm) : WGM;
        u.pm = fm + ((wgid % nig) % gsz); u.pn = (wgid % nig) / gsz; u.a = A + (size_t)u.pm * tstepA; u.b = Bt + (size_t)u.pn * tstepB; u.part = 1; return true;
    }
};
struct TwoPartOrder {
    StaticOrder S; size_t a2off, b2off;
    __device__ bool next(int i, Unit& u) const { if (!S.next(i >> 1, u)) return false; u.part = i & 1; if (i & 1) { u.a += a2off; u.b += b2off; } return true; }
};

template <class Epi, class Sched>
__device__ __forceinline__ void gemm_phase(LAS unsigned char* lds, const Gemm g, const Sched& S, const Epi& E) {
    int tid_ = threadIdx.x; asm volatile("" : "+v"(tid_));
    const int tid = tid_, wid = __builtin_amdgcn_readfirstlane(tid >> 6), lane = tid & 63, wr = wid >> 2, wc = wid & 3, fr = lane & 15, fq = lane >> 4;
    const int K = g.K, nt = K / BK;
    unsigned voffA[2], voffB[2];
#pragma unroll
    for (int i = 0; i < 2; ++i) { int R, C; stage_rc(tid * 16 + i * 8192, R, C); const int Rb = Epi::PERM ? ((R & ~31) + perm32(R & 31)) : R;
        voffA[i] = (unsigned)(R * g.lda + C) * 2u; voffB[i] = (unsigned)(Rb * K + C) * 2u; }
    const size_t kstepA = (size_t)g.kstepA, kstepB = (size_t)(BK * 2);
    const size_t hstepA = (size_t)HALF * g.lda * 2, hstepB = (size_t)HALF * K * 2;
    const unsigned ldsw = (unsigned)wid * 1024u;
    const int aoff = lds_byte(wr * 64 + fr, fq * 8), boff = lds_byte(wc * 32 + fr, fq * 8);
#define PG8_SA(b, h) (((b) * 2 + (h)) * HTB)
#define PG8_SB(b, h) ((4 + (b) * 2 + (h)) * HTB)
#define PG8_STAGE(bufoff, gbase, voff) do { _Pragma("unroll") for (int _i = 0; _i < 2; ++_i) \
        __builtin_amdgcn_global_load_lds((const unsigned*)((const char*)(gbase) + (voff)[_i]), (LAS unsigned*)(lds + (bufoff) + ldsw + _i * 8192), 16, 0, 0); } while (0)
#define PG8_LDA(dst, b, h) do { _Pragma("unroll") for (int m = 0; m < 4; ++m) _Pragma("unroll") for (int k = 0; k < 2; ++k) dst[m][k] = *(const LAS bf16x8*)(lds + PG8_SA(b, h) + aoff + m * 2048 + k * 1024); } while (0)
#define PG8_LDB(dst, b, h) do { _Pragma("unroll") for (int n = 0; n < 2; ++n) _Pragma("unroll") for (int k = 0; k < 2; ++k) dst[n][k] = *(const LAS bf16x8*)(lds + PG8_SB(b, h) + boff + n * 2048 + k * 1024); } while (0)
#define PG8_MMA(ai, bj, At, Bt) do { __builtin_amdgcn_s_setprio(1); _Pragma("unroll") for (int m = 0; m < 4; ++m) _Pragma("unroll") for (int n = 0; n < 2; ++n) _Pragma("unroll") for (int k = 0; k < 2; ++k) \
        acc[ai][bj][m][n] = __builtin_amdgcn_mfma_f32_16x16x32_bf16(Bt[n][k], At[m][k], acc[ai][bj][m][n], 0, 0, 0); __builtin_amdgcn_s_setprio(0); } while (0)
#define PG8_WAIT_V(n) asm volatile("s_waitcnt vmcnt(" #n ")" ::: "memory")
#define PG8_WAIT_L(n) asm volatile("s_waitcnt lgkmcnt(" #n ")" ::: "memory")
#define PG8_BAR __builtin_amdgcn_s_barrier()
#define PG8_SCHED __builtin_amdgcn_sched_barrier(0)
    Unit cur, nxt; int ui = 0;
    if (!S.next(0, cur)) return;
    f32x4 acc[2][2][4][2];
#pragma unroll
    for (int a = 0; a < 2; ++a)
#pragma unroll
        for (int b = 0; b < 2; ++b)
#pragma unroll
            for (int m = 0; m < 4; ++m)
#pragma unroll
                for (int n = 0; n < 2; ++n) acc[a][b][m][n] = (f32x4){0.f, 0.f, 0.f, 0.f};
    bf16x8 At[4][2], B0[2][2], B1[2][2];
    const char* cA = cur.a; const char* cB = cur.b;
    PG8_STAGE(PG8_SB(0, 0), cB, voffB); PG8_STAGE(PG8_SB(0, 1), cB + hstepB, voffB); PG8_STAGE(PG8_SA(0, 0), cA, voffA); PG8_STAGE(PG8_SA(0, 1), cA + hstepA, voffA);
    if (wr == 1) PG8_BAR;
    PG8_WAIT_V(2); PG8_BAR;
    PG8_STAGE(PG8_SB(1, 0), cB + kstepB, voffB); PG8_STAGE(PG8_SA(1, 0), cA + kstepA, voffA); PG8_STAGE(PG8_SB(1, 1), cB + hstepB + kstepB, voffB);
    PG8_WAIT_V(6); PG8_BAR;
    for (;;) {
        const bool has_next = S.next(ui + 1, nxt);
        const char* nA = has_next ? nxt.a : cA; const char* nB = has_next ? nxt.b : cB;
        for (int t = 0; t < nt; t += 2) {
            const bool last = (t == nt - 2);
            const char* a1 = cA + (size_t)(t + 1) * kstepA;
            const char* a2 = last ? nA : cA + (size_t)(t + 2) * kstepA; const char* b2 = last ? nB : cB + (size_t)(t + 2) * kstepB;
            const char* a3 = a2 + kstepA; const char* b3 = b2 + kstepB;
            PG8_LDB(B0, 0, 0); PG8_LDB(B1, 0, 1); PG8_SCHED; PG8_LDA(At, 0, 0); PG8_STAGE(PG8_SA(1, 1), a1 + hstepA, voffA);
            PG8_WAIT_V(8); PG8_WAIT_L(0); PG8_BAR; PG8_MMA(0, 0, At, B0); PG8_MMA(0, 1, At, B1); PG8_BAR; PG8_SCHED;
            PG8_LDA(At, 0, 1); PG8_STAGE(PG8_SB(0, 0), b2, voffB); PG8_STAGE(PG8_SB(0, 1), b2 + hstepB, voffB); PG8_STAGE(PG8_SA(0, 0), a2, voffA);
            PG8_WAIT_V(8); PG8_WAIT_L(0); PG8_BAR; PG8_MMA(1, 0, At, B0); PG8_MMA(1, 1, At, B1); PG8_BAR; PG8_SCHED;
            PG8_LDB(B0, 1, 0); PG8_LDB(B1, 1, 1); PG8_SCHED; PG8_LDA(At, 1, 0); PG8_STAGE(PG8_SA(0, 1), a2 + hstepA, voffA);
            PG8_WAIT_V(8); PG8_WAIT_L(0); PG8_BAR; PG8_MMA(0, 0, At, B0); PG8_MMA(0, 1, At, B1); PG8_BAR; PG8_SCHED;
            PG8_LDA(At, 1, 1); PG8_STAGE(PG8_SB(1, 0), b3, voffB); PG8_STAGE(PG8_SB(1, 1), b3 + hstepB, voffB); PG8_STAGE(PG8_SA(1, 0), a3, voffA);
            PG8_WAIT_V(8); PG8_WAIT_L(0); PG8_BAR; PG8_MMA(1, 0, At, B0); PG8_MMA(1, 1, At, B1); PG8_BAR; PG8_SCHED;
        }
        if (wr == 0) PG8_BAR;
        const bool midpart = Epi::TWO_PART && (cur.part == 0);
        if (midpart) E.mid(acc, cur, wr, wc, fr, fq); else E(acc, cur, wr, wc, fr, fq);
        if (!has_next) break;
        if (!midpart) {
#pragma unroll
        for (int a = 0; a < 2; ++a)
#pragma unroll
            for (int b = 0; b < 2; ++b)
#pragma unroll
                for (int m = 0; m < 4; ++m)
#pragma unroll
                    for (int n = 0; n < 2; ++n) acc[a][b][m][n] = (f32x4){0.f, 0.f, 0.f, 0.f};
        }
        cur = nxt; cA = nA; cB = nB; ++ui;
        if (wr == 1) PG8_BAR;
    }
    PG8_WAIT_V(0);
    PG8_BAR;
#undef PG8_SA
#undef PG8_SB
#undef PG8_STAGE
#undef PG8_LDA
#undef PG8_LDB
#undef PG8_MMA
#undef PG8_WAIT_V
#undef PG8_WAIT_L
#undef PG8_BAR
#undef PG8_SCHED
}
}

typedef f32x4 AccT[2][2][4][2];

__device__ __forceinline__ int vt_keypos(int t) { const int u = (t >> 2) & 15; return (t & ~63) | ((((u & 8) | ((u & 3) << 1) | ((u >> 2) & 1))) << 2) | (t & 3); }
struct EpiZ {
    static constexpr bool PERM = true, TWO_PART = false;
    __device__ __forceinline__ void mid(AccT& acc, const pg8::Unit& u, int wr, int wc, int fr, int fq) const {}
    bf16_t* ZA; bf16_t* MG; bf16_t* QR; bf16_t* VST; bf16_t* VWT; bf16_t* KSB; bf16_t* KWB; const float* rope;
    __device__ __forceinline__ void operator()(const AccT& acc, const pg8::Unit& u, int wr, int wc, int fr, int fq) const {
        const int pn = u.pn, row0 = u.pm * 256 + wr * 64 + fr, cin = wc * 32 + 8 * fq, c8 = 4 * (wc & 1) + fq;
#pragma unroll
        for (int ai = 0; ai < 2; ++ai)
#pragma unroll
            for (int m = 0; m < 4; ++m) {
                const int row = row0 + ai * 128 + m * 16, t = row & (SEQ - 1);
#pragma unroll
                for (int bj = 0; bj < 2; ++bj) {
                    f32x4 v0 = acc[ai][bj][m][0], v1 = acc[ai][bj][m][1];
                    const int c = pn * 256 + bj * 128 + cin;
                    const bool isq = pn < 2, iskv = (pn == 3 || pn == 4);
                    if (isq || (iskv && bj == 0)) {
                        if (isq) { v0 = v0 * QSCALE; v1 = v1 * QSCALE; u32x4 w; w.x = cvtpk(v0[0], v0[1]); w.y = cvtpk(v0[2], v0[3]); w.z = cvtpk(v1[0], v1[1]); w.w = cvtpk(v1[2], v1[3]);
                            *(u32x4*)(ZA + (size_t)row * ZP + c) = w; }
                        const float* rp = rope + ((size_t)t * 32 + 4 * c8) * 2; const f32x4 r0 = *(const f32x4*)rp, r1 = *(const f32x4*)(rp + 4);
                        f32x4 o1, o2;
                        o1[0] = v0[0] * r0[0] - v1[0] * r0[1]; o2[0] = v0[0] * r0[1] + v1[0] * r0[0];
                        o1[1] = v0[1] * r0[2] - v1[1] * r0[3]; o2[1] = v0[1] * r0[3] + v1[1] * r0[2];
                        o1[2] = v0[2] * r1[0] - v1[2] * r1[1]; o2[2] = v0[2] * r1[1] + v1[2] * r1[0];
                        o1[3] = v0[3] * r1[2] - v1[3] * r1[3]; o2[3] = v0[3] * r1[3] + v1[3] * r1[2];
                        u32x4 w; w.x = cvtpk(o1[0], o1[1]); w.y = cvtpk(o1[2], o1[3]); w.z = cvtpk(o2[0], o2[1]); w.w = cvtpk(o2[2], o2[3]);
                        if (isq) *(u32x4*)(QR + (size_t)row * 512 + c) = w;
                        else { bf16_t* KB = (pn == 3) ? KSB : KWB; *(u32x4*)(KB + (((size_t)((row >> 13) * 2 + (wc >> 1)) * SEQ + t) * 64 + 32 * (wc & 1) + 8 * fq)) = w; }
                    } else if (iskv) {
                        bf16_t* VT = (pn == 3) ? VST : VWT; const int gg = wc >> 1, d0 = 32 * (wc & 1) + 8 * fq, b = row >> 13;
                        bf16_t* base = VT + ((((size_t)(b * 2 + gg) * 128 + (t >> 6)) * 64 + d0) * 64) + (vt_keypos(t) & 63);
#pragma unroll
                        for (int e = 0; e < 4; ++e) { base[e * 64] = f2bf(v0[e]); base[(4 + e) * 64] = f2bf(v1[e]); }
                    } else {
                        u32x4 w; w.x = cvtpk(v0[0], v0[1]); w.y = cvtpk(v0[2], v0[3]); w.z = cvtpk(v1[0], v1[1]); w.w = cvtpk(v1[2], v1[3]);
                        if (pn < 12) *(u32x4*)(ZA + (size_t)row * ZP + ((pn >= 5) ? c - 512 : c)) = w; else *(u32x4*)(MG + (size_t)row * 2048 + (c - 3072)) = w;
                    }
                }
            }
    }
};
__device__ __forceinline__ float gelu_tanh(float x) { const float u = 0.7978845608028654f * (x + 0.044715f * x * x * x); const float e = fast_exp2(u * (2.0f * LOG2E)); const float th = 1.0f - 2.0f * frcp(e + 1.0f); return 0.5f * x * (1.0f + th); }
struct EpiCmp {
    static constexpr bool PERM = true, TWO_PART = false;
    __device__ __forceinline__ void mid(AccT& acc, const pg8::Unit& u, int wr, int wc, int fr, int fq) const {}
    bf16_t* H; const float* b1p;
    __device__ __forceinline__ void operator()(const AccT& acc, const pg8::Unit& u, int wr, int wc, int fr, int fq) const {
        const int kv = u.pm >> 4, rt = u.pm & 15; const int row0 = rt * 256 + wr * 64 + fr;
#pragma unroll
        for (int bj = 0; bj < 2; ++bj) { const int c = bj * 128 + wc * 32 + 8 * fq; const float* bq = b1p + kv * 256 + c; const f32x4 ba = (*(const f32x4*)bq + *(const f32x4*)(bq + 512)) + (*(const f32x4*)(bq + 1024) + *(const f32x4*)(bq + 1536)), bb = (*(const f32x4*)(bq + 4) + *(const f32x4*)(bq + 516)) + (*(const f32x4*)(bq + 1028) + *(const f32x4*)(bq + 1540));
#pragma unroll
            for (int ai = 0; ai < 2; ++ai)
#pragma unroll
                for (int m = 0; m < 4; ++m) { const int row = row0 + ai * 128 + m * 16; const f32x4 v0 = acc[ai][bj][m][0] + ba, v1 = acc[ai][bj][m][1] + bb;
                    u32x4 w; w.x = cvtpk(gelu_tanh(v0[0]), gelu_tanh(v0[1])); w.y = cvtpk(gelu_tanh(v0[2]), gelu_tanh(v0[3])); w.z = cvtpk(gelu_tanh(v1[0]), gelu_tanh(v1[1])); w.w = cvtpk(gelu_tanh(v1[2]), gelu_tanh(v1[3]));
                    *(u32x4*)(H + ((size_t)kv * 4096 + row) * 256 + c) = w; } }
    }
};
struct EpiMerge {
    static constexpr bool PERM = true, TWO_PART = true;
    const bf16_t* MG; bf16_t* MIXP;
    static __device__ __forceinline__ void ratio4(f32x4& r, unsigned a0, unsigned a1, unsigned b0, unsigned b1) {
        r[0] = (1.f + __expf(-bflo(b0))) * frcp(1.f + __expf(-bflo(a0))); r[1] = (1.f + __expf(-bfhi(b0))) * frcp(1.f + __expf(-bfhi(a0)));
        r[2] = (1.f + __expf(-bflo(b1))) * frcp(1.f + __expf(-bflo(a1))); r[3] = (1.f + __expf(-bfhi(b1))) * frcp(1.f + __expf(-bfhi(a1))); }
    __device__ __forceinline__ void mid(AccT& acc, const pg8::Unit& u, int wr, int wc, int fr, int fq) const {
        const unsigned off0 = (unsigned)(u.pm * 256 + wr * 64 + fr) * 4096u + (unsigned)(u.pn * 256 + wc * 32 + 8 * fq) * 2u;
        const char* mg = (const char*)MG;
        u32x4 ga[2][2], gb[2][2];
#define EM_LOAD(BUF, GRP) do { _Pragma("unroll") for (int bj = 0; bj < 2; ++bj) { const unsigned off = off0 + (unsigned)((((GRP) >> 2) * 128 + ((GRP) & 3) * 16)) * 4096u + (unsigned)(bj * 256); \
            ga[BUF][bj] = *(const u32x4*)(mg + off); gb[BUF][bj] = *(const u32x4*)(mg + off + 2048u); } } while (0)
        EM_LOAD(0, 0);
#pragma unroll
        for (int grp = 0; grp < 8; ++grp) { const int ai = grp >> 2, m = grp & 3, cb = grp & 1;
            if (grp + 1 < 8) EM_LOAD((grp + 1) & 1, grp + 1);
#pragma unroll
            for (int bj = 0; bj < 2; ++bj) { f32x4 r0, r1; ratio4(r0, ga[cb][bj].x, ga[cb][bj].y, gb[cb][bj].x, gb[cb][bj].y); ratio4(r1, ga[cb][bj].z, ga[cb][bj].w, gb[cb][bj].z, gb[cb][bj].w);
                acc[ai][bj][m][0] = acc[ai][bj][m][0] * r0; acc[ai][bj][m][1] = acc[ai][bj][m][1] * r1; }
            asm volatile("" ::: "memory"); }
#undef EM_LOAD
    }
    __device__ __forceinline__ void operator()(const AccT& acc, const pg8::Unit& u, int wr, int wc, int fr, int fq) const {
        const int row0 = u.pm * 256 + wr * 64 + fr, c0 = u.pn * 256 + wc * 32 + 8 * fq;
#pragma unroll
        for (int ai = 0; ai < 2; ++ai)
#pragma unroll
            for (int m = 0; m < 4; ++m) { const int row = row0 + ai * 128 + m * 16;
#pragma unroll
                for (int bj = 0; bj < 2; ++bj) { const int c = c0 + bj * 128; const u32x4 gw = *(const u32x4*)(MG + (size_t)row * 2048 + 1024 + c); const f32x4 a = acc[ai][bj][m][0], b2 = acc[ai][bj][m][1];
                    u32x4 w; w.x = cvtpk(a[0] * sigmoidf_(bflo(gw.x)), a[1] * sigmoidf_(bfhi(gw.x))); w.y = cvtpk(a[2] * sigmoidf_(bflo(gw.y)), a[3] * sigmoidf_(bfhi(gw.y)));
                    w.z = cvtpk(b2[0] * sigmoidf_(bflo(gw.z)), b2[1] * sigmoidf_(bfhi(gw.z))); w.w = cvtpk(b2[2] * sigmoidf_(bflo(gw.w)), b2[3] * sigmoidf_(bfhi(gw.w)));
                    *(u32x4*)(MIXP + (size_t)row * 1024 + c) = w; } }
    }
};
struct EpiBf16Plain {
    static constexpr bool PERM = true, TWO_PART = false;
    bf16_t* O; int ldc;
    __device__ __forceinline__ void mid(AccT& acc, const pg8::Unit& u, int wr, int wc, int fr, int fq) const {}
    __device__ __forceinline__ void operator()(const AccT& acc, const pg8::Unit& u, int wr, int wc, int fr, int fq) const {
        const int row0 = u.pm * 256 + wr * 64 + fr, c0 = u.pn * 256 + wc * 32 + 8 * fq;
#pragma unroll
        for (int ai = 0; ai < 2; ++ai)
#pragma unroll
            for (int m = 0; m < 4; ++m) { const int row = row0 + ai * 128 + m * 16;
#pragma unroll
                for (int bj = 0; bj < 2; ++bj) { const f32x4 v0 = acc[ai][bj][m][0], v1 = acc[ai][bj][m][1];
                    u32x4 w; w.x = cvtpk(v0[0], v0[1]); w.y = cvtpk(v0[2], v0[3]); w.z = cvtpk(v1[0], v1[1]); w.w = cvtpk(v1[2], v1[3]);
                    *(u32x4*)(O + (size_t)row * ldc + c0 + bj * 128) = w; } }
    }
};
struct EpiSwiGLU {
    static constexpr bool PERM = true, TWO_PART = false;
    __device__ __forceinline__ void mid(AccT& acc, const pg8::Unit& u, int wr, int wc, int fr, int fq) const {}
    bf16_t* ACT;
    __device__ __forceinline__ void operator()(const AccT& acc, const pg8::Unit& u, int wr, int wc, int fr, int fq) const {
        const int row0 = u.pm * 256 + wr * 64 + fr, c = u.pn * 128 + wc * 32 + 8 * fq;
#pragma unroll
        for (int ai = 0; ai < 2; ++ai)
#pragma unroll
            for (int m = 0; m < 4; ++m) { const int row = row0 + ai * 128 + m * 16; float o[8];
#pragma unroll
                for (int n = 0; n < 2; ++n)
#pragma unroll
                    for (int e = 0; e < 4; ++e) { const float gt = acc[ai][0][m][n][e], up = acc[ai][1][m][n][e]; o[n * 4 + e] = gt * sigmoidf_(gt) * up; }
                u32x4 w; w.x = cvtpk(o[0], o[1]); w.y = cvtpk(o[2], o[3]); w.z = cvtpk(o[4], o[5]); w.w = cvtpk(o[6], o[7]);
                *(u32x4*)(ACT + (size_t)row * DFF + c) = w; }
    }
};
struct CmpOrder {
    int c; const bf16_t* ZA; const bf16_t* W1kT; const bf16_t* W1vT;
    __device__ bool next(int i, pg8::Unit& u) const {
        if (i > 0 || c >= 32) return false;
        u.pm = c; u.pn = 0; const int kv = c >> 4, bg = (c >> 1) & 7, nt2 = c & 1, b = bg >> 1, gg = bg & 1;
        u.a = (const char*)(ZA + ((size_t)(b * SEQ + 16 * 256 * nt2)) * ZP + C_KC + kv * 128 + gg * 64);
        u.b = (const char*)(kv ? W1vT : W1kT); u.part = 1; return true;
    }
};

constexpr size_t MiB = 1u << 20;
constexpr size_t WS_CTL = 0, CTL_ZERO_BYTES = 64 * 1024;
constexpr size_t WS_WIN = 1 * MiB;
constexpr size_t WS_WA = 11 * MiB;
constexpr size_t WS_WB = 12 * MiB;
constexpr size_t WS_WOUT = 13 * MiB;
constexpr size_t WS_WGU = 15 * MiB;
constexpr size_t WS_WD = 26 * MiB;
constexpr size_t WS_W1K = 32 * MiB;
constexpr size_t WS_W1V = 33 * MiB;
constexpr size_t WS_ROPE = 34 * MiB;
constexpr size_t WS_B1P = 36 * MiB;
constexpr size_t WS_W2W = 36 * MiB + 65536;
constexpr size_t WS_W2A = WS_W2W + 32768, WS_WGT = WS_W2A + 32768;
constexpr size_t WS_BON = 37 * MiB;
constexpr size_t WS_XN = 40 * MiB;
constexpr size_t WS_ZA = 104 * MiB;
constexpr size_t WS_KSB = 264 * MiB, WS_KWB = 272 * MiB;
constexpr size_t WS_MG = 296 * MiB;
constexpr size_t WS_QR = 424 * MiB;
constexpr size_t WS_VST = 456 * MiB;
constexpr size_t WS_VWT = 464 * MiB;
constexpr size_t WS_KC = 472 * MiB;
constexpr size_t WS_VCT = 473 * MiB;
constexpr size_t WS_HID = 474 * MiB;
constexpr size_t WS_AA = 478 * MiB;
constexpr size_t WS_END = 512 * MiB;
constexpr int CW_BAR = 1024;
constexpr int CW_Q_TR = 896;
constexpr int CW_Q_POST = 768, CW_SCAN_DONE = 832;
constexpr int CW_Q_CHUNK = 5120, CW_Q_NSA = 128;

constexpr int RING_BYTES = 131072, LDSCTL_OFF = RING_BYTES, MISC_OFF = LDSCTL_OFF + 320, LDS_BYTES = 147456, NWAVES = 8;

typedef GAS unsigned gu32;
#define RLX_AGENT __ATOMIC_RELAXED, __HIP_MEMORY_SCOPE_AGENT
#define LDS_WAIT() asm volatile("s_waitcnt lgkmcnt(0)" ::: "memory")
#define VM_WAIT() asm volatile("s_waitcnt vmcnt(0)" ::: "memory")

#define XB_TMO      128
#define XB_XCNT(j)  (256  + 64 * (j))
#define XB_XSUB(j)  (1280 + 64 * (j))
#define XB_XGEN(j)  (2304 + 64 * (j))
#define XB_TOP      3328
#define XB_TOPGEN   3392
#define XCD_BAR_WORDS 3456
#define XB_SPIN_CAP (1u << 22)
__device__ __forceinline__ unsigned xb_ld(unsigned* p)              { return __hip_atomic_load(p, __ATOMIC_RELAXED, __HIP_MEMORY_SCOPE_AGENT); }
__device__ __forceinline__ unsigned xb_add(unsigned* p, unsigned v) { return __hip_atomic_fetch_add(p, v, __ATOMIC_RELAXED, __HIP_MEMORY_SCOPE_AGENT); }
__device__ __forceinline__ unsigned xb_xcc_id() { return (unsigned)__builtin_amdgcn_s_getreg((3 << 11) | 20) & 0xFu; }
#define XB_SPIN(cond, bar) do { unsigned _sp = 0; while (cond) { __builtin_amdgcn_s_sleep(1); \
    if ((++_sp & 255u) == 0u) { if (xb_ld(&(bar)[XB_TMO])) break; if (_sp > XB_SPIN_CAP) { atomicAdd(&(bar)[XB_TMO], 1u); break; } } } } while (0)
struct XcdBarrier { unsigned* bar; unsigned x; volatile LAS unsigned* st; };
__device__ __forceinline__ XcdBarrier xcd_barrier_post(unsigned* bar, volatile LAS unsigned* st) {
    XcdBarrier b; b.bar = bar; b.x = xb_xcc_id(); b.st = st;
    if (threadIdx.x == 0) (void)xb_add(&bar[XB_XCNT(b.x)], 1u);
    return b;
}
__device__ __forceinline__ void xcd_barrier_complete(unsigned* bar, unsigned x, unsigned& nloc, unsigned& nx) {
    const unsigned G = gridDim.x * gridDim.y * gridDim.z;
    unsigned sum, cnt, mine, sp = 0u;
    for (;;) {
        sum = 0u; cnt = 0u; mine = 0u;
#pragma unroll
        for (unsigned j = 0; j < 16; ++j) { const unsigned c = xb_ld(&bar[XB_XCNT(j)]); sum += c; cnt += (c > 0u) ? 1u : 0u; mine = (j == x) ? c : mine; }
        if (sum == G) break;
        __builtin_amdgcn_s_sleep(1);
        if ((++sp & 255u) == 0u) { if (xb_ld(&bar[XB_TMO])) break; if (sp > XB_SPIN_CAP) { atomicAdd(&bar[XB_TMO], 1u); break; } }
    }
    nloc = mine > 0u ? mine : 1u; nx = cnt > 0u ? cnt : 1u;
}
__device__ __forceinline__ void xcd_barrier(const XcdBarrier& b) {
    asm volatile("s_waitcnt vmcnt(0)" ::: "memory");
    __syncthreads();
    if (threadIdx.x == 0) {
        unsigned* bar = b.bar;
        __builtin_amdgcn_s_waitcnt(0);
        unsigned nloc = b.st[0], nx = b.st[1];
        if (nloc == 0u) { xcd_barrier_complete(bar, b.x, nloc, nx); b.st[0] = nloc; b.st[1] = nx; }
        const unsigned old = xb_add(&bar[XB_XSUB(b.x)], 1u);
        const unsigned gen = old / nloc;
        if (old + 1u == (gen + 1u) * nloc) {
            __builtin_amdgcn_fence(__ATOMIC_RELEASE, "agent");
            asm volatile("s_waitcnt vmcnt(0)" ::: "memory");
            const unsigned og = xb_add(&bar[XB_TOP], 1u);
            const unsigned tg = og / nx;
            if (og + 1u == (tg + 1u) * nx) xb_add(&bar[XB_TOPGEN], 1u);
            else XB_SPIN(xb_ld(&bar[XB_TOPGEN]) == tg, bar);
            __builtin_amdgcn_fence(__ATOMIC_ACQUIRE, "agent");
            xb_add(&bar[XB_XGEN(b.x)], 1u);
            asm volatile("s_waitcnt vmcnt(0)" ::: "memory");
        } else {
            XB_SPIN(xb_ld(&bar[XB_XGEN(b.x)]) == gen, bar);
            __builtin_amdgcn_fence(__ATOMIC_ACQUIRE, "agent");
            asm volatile("s_waitcnt vmcnt(0)" ::: "memory");
        }
    }
    __syncthreads();
}

struct Args { const float* in[36]; float* out; unsigned char* ws; };
struct Frame {
    const Args& A;
    LAS unsigned char* lds; volatile LAS unsigned* MISC; unsigned* ctl;
    int tid, lane, wave, vcu, G, gw, NGW, z; GAS unsigned char* wsb;
};
#define PHASE_FRAME(F, F0) Frame F = F0; asm volatile("" : "+v"(F.tid), "+v"(F.lane), "+s"(F.wave), "+s"(F.z), "+s"(F.wsb), "+s"(F.gw), "+s"(F.vcu))
enum { I_X = 0, I_N1PRE, I_N1POST, I_WIN, I_PEK, I_W1K, I_B1K, I_W2K, I_PEV, I_W1V, I_B1V, I_W2V, I_MUR, I_MUK, I_MUV, I_MUW, I_MUA, I_MUG, I_W0, I_WW2, I_A0, I_WA2, I_WG2,
       I_KK, I_KA, I_RK, I_LNXW, I_LNXB, I_WBA, I_WBB, I_WOUT, I_N2PRE, I_N2POST, I_WGATE, I_WUP, I_WDOWN };

__device__ __forceinline__ float wave_sum(float v) {
#pragma unroll
    for (int o = 1; o < 64; o <<= 1) v += __shfl_xor(v, o);
    return v;
}
__device__ __forceinline__ float dpp_sum(float v) {
    int x = __builtin_bit_cast(int, v);
#define DPP_ADD(ctrl, rm) { const int t_ = __builtin_amdgcn_update_dpp(0, x, ctrl, rm, 0xF, false); x = __builtin_bit_cast(int, __builtin_bit_cast(float, x) + __builtin_bit_cast(float, t_)); }
    DPP_ADD(0xB1, 0xF) DPP_ADD(0x4E, 0xF) DPP_ADD(0x141, 0xF) DPP_ADD(0x140, 0xF) DPP_ADD(0x142, 0xA) DPP_ADD(0x143, 0xC)
#undef DPP_ADD
    return __builtin_bit_cast(float, __builtin_amdgcn_readlane(x, 63));
}

__device__ __forceinline__ int rope_perm64(int pp) { const int c8 = pp >> 3, e = pp & 7; return (e < 4) ? 4 * c8 + e : 32 + 4 * c8 + (e - 4); }
__device__ __forceinline__ int zcol_src(int p) {
    if (p < 512) return (p & ~63) + rope_perm64(p & 63);
    if (p < 768) return p;
    if (p < 896) return 768 + ((p - 768) & ~63) + rope_perm64((p - 768) & 63);
    if (p < 1024) return p;
    if (p < 1152) return 1024 + ((p - 1024) & ~63) + rope_perm64((p - 1024) & 63);
    if (p < 1280) return p;
    if (p < 2816) return 1304 + (p - 1280);
    if (p < 2976) return 2840 + (p - 2816);
    if (p < 3000) return 1280 + (p - 2976);
    if (p < 3072) return -1;
    return 3000 + (p - 3072);
}
template <class Src>
__device__ __forceinline__ void transpose_item(const Src& src, int ldw, bf16_t* WT, int ldk, LAS float* scr, int kb, int nb, int lane) {
    const int k0 = 64 * kb, n0 = 32 * nb, kr = lane >> 3, nq = lane & 7;
    const float* cp = src(n0 + 4 * nq);
    f32x4 v[8];
#pragma unroll
    for (int i = 0; i < 8; ++i) v[i] = cp ? *(const f32x4*)(cp + (size_t)(k0 + 8 * i + kr) * ldw) : (f32x4){0.f, 0.f, 0.f, 0.f};
#pragma unroll
    for (int i = 0; i < 8; ++i) { LAS float* d = scr + (8 * i + kr) * 33 + 4 * nq; d[0] = v[i][0]; d[1] = v[i][1]; d[2] = v[i][2]; d[3] = v[i][3]; }
    LDS_WAIT(); asm volatile("" ::: "memory");
    const int c = lane & 7;
#pragma unroll
    for (int j = 0; j < 4; ++j) { const int n = (lane >> 3) + 8 * j; const LAS float* s = scr + (8 * c) * 33 + n;
        u32x4 o; o.x = cvtpk(s[0 * 33], s[1 * 33]); o.y = cvtpk(s[2 * 33], s[3 * 33]); o.z = cvtpk(s[4 * 33], s[5 * 33]); o.w = cvtpk(s[6 * 33], s[7 * 33]);
        *(u32x4*)(WT + (size_t)(n0 + n) * ldk + k0 + 8 * c) = o; }
    LDS_WAIT(); asm volatile("" ::: "memory");
}

constexpr int TR_IN = 16 * 160, TR_A = 8 * 32, TR_O = 16 * 32, TR_GU = 16 * 176, TR_D = 44 * 32, TR_1 = 32 * 8;
constexpr int TR_DEF0 = TR_IN, TR_DEF1 = TR_IN + 2 * TR_A + TR_O + TR_GU + TR_D, TR_ALL = TR_DEF1 + 2 * TR_1;
__device__ __forceinline__ void tr_item(Frame& F, int it, LAS float* scr, int lane) {
    constexpr int I_IN = TR_IN, I_A = TR_A, I_O = TR_O, I_GU = TR_GU, I_D = TR_D, I_1 = TR_1;
    int r = it;
        if (r < I_IN) { const float* W = F.A.in[(I_WIN) + F.z]; transpose_item([&](int n) -> const float* { const int s = zcol_src(n); return s < 0 ? nullptr : W + s; }, 5048, ((bf16_t*)(F.wsb + WS_WIN)), 1024, scr, r / 160, r % 160, lane); return; } r -= I_IN;
        if (r < I_A) { const float* W = F.A.in[(I_WBA) + F.z]; transpose_item([&](int n) -> const float* { return W + n; }, 1024, ((bf16_t*)(F.wsb + WS_WA)), 512, scr, r / 32, r % 32, lane); return; } r -= I_A;
        if (r < I_A) { const float* W = F.A.in[(I_WBB) + F.z]; transpose_item([&](int n) -> const float* { return W + n; }, 1024, ((bf16_t*)(F.wsb + WS_WB)), 512, scr, r / 32, r % 32, lane); return; } r -= I_A;
        if (r < I_O) { const float* W = F.A.in[(I_WOUT) + F.z]; transpose_item([&](int n) -> const float* { return W + n; }, 1024, ((bf16_t*)(F.wsb + WS_WOUT)), 1024, scr, r / 32, r % 32, lane); return; } r -= I_O;
        if (r < I_GU) { const float* Wg = F.A.in[(I_WGATE) + F.z]; const float* Wu = F.A.in[(I_WUP) + F.z];
            transpose_item([&](int n) -> const float* { const int tl = n >> 8, w = n & 255; return (w < 128) ? Wg + tl * 128 + w : Wu + tl * 128 + (w - 128); }, DFF, ((bf16_t*)(F.wsb + WS_WGU)), 1024, scr, r / 176, r % 176, lane); return; } r -= I_GU;
        if (r < I_D) { const float* W = F.A.in[(I_WDOWN) + F.z]; transpose_item([&](int n) -> const float* { return W + n; }, 1024, ((bf16_t*)(F.wsb + WS_WD)), DFF, scr, r / 32, r % 32, lane); return; } r -= I_D;
        if (r < I_1) { const float* W = F.A.in[(I_W1K) + F.z]; transpose_item([&](int n) -> const float* { return W + n; }, 256, ((bf16_t*)(F.wsb + WS_W1K)), 2048, scr, r / 8, r % 8, lane); return; } r -= I_1;
        { const float* W = F.A.in[(I_W1V) + F.z]; transpose_item([&](int n) -> const float* { return W + n; }, 256, ((bf16_t*)(F.wsb + WS_W1V)), 2048, scr, r / 8, r % 8, lane); }
}
__device__ __forceinline__ void deferred_transposes(Frame& F0) {
    PHASE_FRAME(F, F0);
    LAS float* scr = (LAS float*)(F.lds + F.wave * 16384); LAS int* slot = (LAS int*)(F.lds + LDS_BYTES - 256) + 16;
    constexpr int NG = (TR_DEF1 - TR_DEF0 + 7) / 8;
    __syncthreads();
    for (;;) {
        if (F.tid == 0) *slot = (int)__hip_atomic_fetch_add(F.ctl + CW_Q_TR, 1u, RLX_AGENT);
        __syncthreads();
        const int gi = __builtin_amdgcn_readfirstlane(*slot);
        __syncthreads();
        if (gi >= NG) break;
        const int it = TR_DEF0 + gi * 8 + F.wave;
        if (it < TR_DEF1) tr_item(F, it, scr, F.lane);
    }
}

__device__ __forceinline__ void p0_prologue(Frame& F0) {
    PHASE_FRAME(F, F0);
    LAS float* scr = (LAS float*)(F.lds + F.wave * 16384);
    const int gw = F.gw, NGW = F.NGW, lane = F.lane;
    for (int it = gw; it < TR_IN + 2 * TR_1; it += NGW) tr_item(F, (it < TR_IN) ? it : it + (TR_DEF1 - TR_DEF0), scr, lane);
    { const float* gp = F.A.in[(I_N1PRE) + F.z];
      f32x4 gv[4];
#pragma unroll
      for (int j = 0; j < 4; ++j) gv[j] = ((const f32x4*)gp)[lane + 64 * j];
      for (int m = gw; m < NTOK; m += 2 * NGW) {
        const int m2 = m + NGW;
        const f32x4* xr = (const f32x4*)(F.A.in[(I_X) + F.z] + (size_t)m * DM) + lane; const f32x4* xr2 = (const f32x4*)(F.A.in[(I_X) + F.z] + (size_t)m2 * DM) + lane; f32x4 v[4], w4[4]; float s = 0.f, s2 = 0.f;
#pragma unroll
        for (int j = 0; j < 4; ++j) { v[j] = xr[64 * j]; w4[j] = xr2[64 * j]; }
#pragma unroll
        for (int j = 0; j < 4; ++j) { s += (v[j].x * v[j].x + v[j].y * v[j].y) + (v[j].z * v[j].z + v[j].w * v[j].w); s2 += (w4[j].x * w4[j].x + w4[j].y * w4[j].y) + (w4[j].z * w4[j].z + w4[j].w * w4[j].w); }
        const float rs = 1.0f / sqrtf(wave_sum(s) * (1.f / DM) + 1e-6f), rs2 = 1.0f / sqrtf(wave_sum(s2) * (1.f / DM) + 1e-6f);
        u32x2* o8 = (u32x2*)(((bf16_t*)(F.wsb + WS_XN)) + (size_t)m * DM) + lane; u32x2* o82 = (u32x2*)(((bf16_t*)(F.wsb + WS_XN)) + (size_t)m2 * DM) + lane;
#pragma unroll
        for (int j = 0; j < 4; ++j) { u32x2 w; w.x = cvtpk(v[j].x * rs * gv[j].x, v[j].y * rs * gv[j].y); w.y = cvtpk(v[j].z * rs * gv[j].z, v[j].w * rs * gv[j].w); o8[64 * j] = w;
            u32x2 w2; w2.x = cvtpk(w4[j].x * rs2 * gv[j].x, w4[j].y * rs2 * gv[j].y); w2.y = cvtpk(w4[j].z * rs2 * gv[j].z, w4[j].w * rs2 * gv[j].w); o82[64 * j] = w2; } } }
    { const int gt = gw * 64 + lane, NT = NGW * 64;
      for (int i = gt; i < SEQ * 32; i += NT) { const int t = i >> 5, f = i & 31; const float inv = 1.0f / powf(10000.0f, (float)(2 * f) / 64.0f); const float ang = (float)t * inv; float sn, cs; sincosf(ang, &sn, &cs); ((float*)(F.wsb + WS_ROPE))[2 * i] = cs; ((float*)(F.wsb + WS_ROPE))[2 * i + 1] = sn; } }
    { const int gt = gw * 64 + lane, NT = NGW * 64;
      for (int i = gt; i < 512 * 32; i += NT) { const int cch = i >> 5, r = i & 31; ((bf16_t*)(F.wsb + WS_W2W))[i] = f2bf(F.A.in[(I_WW2) + F.z][(size_t)r * 512 + cch]); ((bf16_t*)(F.wsb + WS_W2A))[i] = f2bf(F.A.in[(I_WA2) + F.z][(size_t)r * 512 + cch]); }
      for (int i = gt; i < 512 * 96; i += NT) { const int cch = i / 96, r = i % 96; ((bf16_t*)(F.wsb + WS_WGT))[i] = f2bf(F.A.in[(I_WG2) + F.z][(size_t)r * 512 + cch]); } }
    for (int u = gw; u < 2048; u += NGW) { const int o = u & 511, qtr = u >> 9, kv = o >> 8, j = o & 255; const float* pe = F.A.in[(kv ? I_PEV : I_PEK) + F.z]; const float* w1 = F.A.in[(kv ? I_W1V : I_W1K) + F.z]; float s = 0.f;
#pragma unroll
        for (int i = 0; i < 8; ++i) { const int k = 512 * qtr + lane + 64 * i; s += pe[k] * w1[(size_t)k * 256 + j]; }
        s = wave_sum(s); if (lane == 0) ((float*)(F.wsb + WS_B1P))[qtr * 512 + o] = s + ((qtr == 0) ? F.A.in[(kv ? I_B1V : I_B1K) + F.z][j] : 0.f); }
}

__device__ __forceinline__ void cmp_stage2(Frame& F0, int unit) {
    PHASE_FRAME(F, F0);
    const int lane = F.lane;
    for (int r_ = F.wave; r_ < 256; r_ += NWAVES) {
        const int kv = unit >> 4, m = (unit & 15) * 256 + r_, bg = m >> 9, n = m & 511;
        const float* w2 = F.A.in[(kv ? I_W2V : I_W2K) + F.z]; const int dcol = kv ? lane : rope_perm64(lane);
        const bf16_t* h = ((bf16_t*)(F.wsb + WS_HID)) + ((size_t)kv * 4096 + m) * 256; float s = 0.f;
        const unsigned hv0 = ((const unsigned*)h)[lane], hv1 = ((const unsigned*)h)[64 + lane];
#pragma unroll 8
        for (int j = 0; j < 64; ++j) { const unsigned a = __shfl(hv0, j), b = __shfl(hv1, j);
            s += bflo(a) * w2[(size_t)(2 * j) * 64 + dcol] + bfhi(a) * w2[(size_t)(2 * j + 1) * 64 + dcol] + bflo(b) * w2[(size_t)(128 + 2 * j) * 64 + dcol] + bfhi(b) * w2[(size_t)(129 + 2 * j) * 64 + dcol]; }
        if (n == 511) s = 0.f;
        if (kv == 0) ((bf16_t*)(F.wsb + WS_KC))[((size_t)bg * 512 + n) * 64 + lane] = f2bf(s); else ((bf16_t*)(F.wsb + WS_VCT))[((size_t)bg * 64 + lane) * 512 + vt_keypos(n)] = f2bf(s);
    }
}

__device__ __forceinline__ void rwkv_prep(Frame& F0) {
    PHASE_FRAME(F, F0);
    const int lane = F.lane, c0 = lane * 8;
    const float* ww2 = F.A.in[(I_WW2) + F.z]; const float* wa2 = F.A.in[(I_WA2) + F.z];
    for (int it = F.gw; it < NTOK / 4; it += F.NGW) {
        const int t0 = it * 4; float val[4];
#pragma unroll
        for (int q = 0; q < 4; ++q) { const int t = t0 + q; const float z = bf2f(((bf16_t*)(F.wsb + WS_ZA))[(size_t)t * ZP + C_WLO + lane]); const float zp = (t & (SEQ - 1)) ? bf2f(((bf16_t*)(F.wsb + WS_ZA))[(size_t)(t - 1) * ZP + C_WLO + lane]) : 0.f;
            const float mu = (lane < 32) ? F.A.in[(I_MUW) + F.z][lane] : F.A.in[(I_MUA) + F.z][lane - 32]; const float v = z + (zp - z) * mu; val[q] = (lane < 32) ? tanhf(v) : v; }
        float aw[4][8], aa[4][8];
#pragma unroll
        for (int q = 0; q < 4; ++q)
#pragma unroll
            for (int e = 0; e < 8; ++e) { aw[q][e] = 0.f; aa[q][e] = 0.f; }
#pragma unroll 4
        for (int i = 0; i < 32; ++i) {
            const f32x4 w0a = *(const f32x4*)(ww2 + (size_t)i * 512 + c0), w0b = *(const f32x4*)(ww2 + (size_t)i * 512 + c0 + 4);
            const f32x4 w1a = *(const f32x4*)(wa2 + (size_t)i * 512 + c0), w1b = *(const f32x4*)(wa2 + (size_t)i * 512 + c0 + 4);
#pragma unroll
            for (int q = 0; q < 4; ++q) { const float wv = __shfl(val[q], i), av = __shfl(val[q], 32 + i);
#pragma unroll
                for (int e = 0; e < 4; ++e) { aw[q][e] += wv * w0a[e]; aw[q][4 + e] += wv * w0b[e]; aa[q][e] += av * w1a[e]; aa[q][4 + e] += av * w1b[e]; } }
        }
        const f32x4 w0v0 = *(const f32x4*)(F.A.in[(I_W0) + F.z] + c0), w0v1 = *(const f32x4*)(F.A.in[(I_W0) + F.z] + c0 + 4), a0v0 = *(const f32x4*)(F.A.in[(I_A0) + F.z] + c0), a0v1 = *(const f32x4*)(F.A.in[(I_A0) + F.z] + c0 + 4);
#pragma unroll
        for (int q = 0; q < 4; ++q) { const int t = t0 + q; float lw[8]; unsigned ap[4];
#pragma unroll
            for (int e = 0; e < 8; ++e) { const float wl = ((e < 4) ? w0v0[e & 3] : w0v1[e & 3]) + aw[q][e];
                const float nx = -wl; const float sp = fmaxf(nx, 0.f) + log1pf(expf(-fabsf(nx)));
                lw[e] = -expf(-sp - 0.5f) * LOG2E; }
            *(f32x4*)(((float*)(F.wsb + WS_XN)) + (size_t)t * 512 + c0) = (f32x4){lw[0], lw[1], lw[2], lw[3]}; *(f32x4*)(((float*)(F.wsb + WS_XN)) + (size_t)t * 512 + c0 + 4) = (f32x4){lw[4], lw[5], lw[6], lw[7]};
#pragma unroll
            for (int e = 0; e < 4; ++e) { const float x0 = ((2 * e < 4) ? a0v0[(2 * e) & 3] : a0v1[(2 * e) & 3]) + aa[q][2 * e], x1 = ((2 * e + 1 < 4) ? a0v0[(2 * e + 1) & 3] : a0v1[(2 * e + 1) & 3]) + aa[q][2 * e + 1];
                ap[e] = cvtpk(sigmoidf_(x0), sigmoidf_(x1)); }
            *(u32x4*)(((bf16_t*)(F.wsb + WS_AA)) + (size_t)t * 512 + c0) = (u32x4){ap[0], ap[1], ap[2], ap[3]};
        }
    }
}

#define LDS_BAR() do { asm volatile("s_waitcnt lgkmcnt(0)" ::: "memory"); __builtin_amdgcn_s_barrier(); asm volatile("" ::: "memory"); } while (0)
#define LDS_SPIN_GE(PTR, TGT) do { while ((unsigned)__builtin_amdgcn_readfirstlane((int)*(volatile LAS unsigned*)(PTR)) < (unsigned)(TGT)) __builtin_amdgcn_s_sleep(1); asm volatile("" ::: "memory"); } while (0)
#define LDS_SIGNAL(LANE, PTR) do { asm volatile("s_waitcnt lgkmcnt(0)" ::: "memory"); if ((LANE) == 0) __hip_atomic_fetch_add((LAS unsigned*)(PTR), 1u, __ATOMIC_RELAXED, __HIP_MEMORY_SCOPE_WORKGROUP); asm volatile("" ::: "memory"); } while (0)
__device__ __forceinline__ int nsa_off(int row, int chunk) { return row * 128 + ((chunk ^ ((row >> 1) & 7)) << 4); }
constexpr int CP = 72, SLOT = 8192;
constexpr int L_ATR = 0, L_XA = 1 * SLOT, L_RTR = 3 * SLOT, L_XB = 4 * SLOT, L_BTR = 4 * SLOT, L_KTR = 5 * SLOT, L_BHC = 6 * SLOT, L_KCC = 7 * SLOT, L_VC = 8 * SLOT,
              L_PAR = 9 * SLOT, L_PAC = 10 * SLOT, L_PBC = 11 * SLOT, L_PBR = L_ATR, L_MBR = 12 * SLOT, L_SEG = 13 * SLOT + 1024, L_GC = L_SEG + 2048;
constexpr int CH_GT = 0, CH_WY = 8192, CH_HT = 16384, CH_Y0 = 24576, CH_BYTES = 32768;
__device__ __forceinline__ bf16x8 ldfrag(LAS unsigned char* L, int buf, int row0, int ks, int c, int g) { return *(const LAS bf16x8*)(L + buf + nsa_off(row0 + c, 4 * ks + g)); }
__device__ __forceinline__ void store_T(LAS unsigned char* L, int buf, int m0, int n0, const f32x4 v, int c, int g) { u32x2 w; w.x = cvtpk(v[0], v[1]); w.y = cvtpk(v[2], v[3]); *(LAS u32x2*)(L + buf + nsa_off(n0 + c, (m0 >> 3) + (g >> 1)) + 8 * (g & 1)) = w; }
__device__ __forceinline__ void store_R(LAS unsigned char* L, int buf, int m0, int n0, const f32x4 v, int c, int g) {
#pragma unroll
    for (int r = 0; r < 4; ++r) *(LAS bf16_t*)(L + buf + nsa_off(m0 + 4 * g + r, (n0 + c) >> 3) + 2 * ((n0 + c) & 7)) = f2bf(v[r]); }
__device__ __forceinline__ f32x4 ld_c4(LAS unsigned char* L, int buf, int row, int col0) { const u32x2 w = *(const LAS u32x2*)(L + buf + nsa_off(row, col0 >> 3) + 2 * (col0 & 7)); return (f32x4){bflo(w.x), bfhi(w.x), bflo(w.y), bfhi(w.y)}; }
#define MF16(a, b, cc) __builtin_amdgcn_mfma_f32_16x16x32_bf16(a, b, cc, 0, 0, 0)

__device__ __forceinline__ void rwkv_chunk_phase(Frame& F0, unsigned char* CH) {
    PHASE_FRAME(F, F0);
    const int lane = F.lane, w = F.wave, c = lane & 15, g = lane >> 4, mi = w >> 1, half = w & 1;
    LAS unsigned char* L = F.lds;
    const f32x4 Z4 = (f32x4){0.f, 0.f, 0.f, 0.f};
    LAS int* qslot = (LAS int*)(L + L_SEG + 4096);
    struct ChunkIn { u32x2 wc, wp, ac, ap, gc[3], gp[3]; bf16_t rz[9], kz[9], vz[9]; };
#define CHUNK_LOAD(D, CID) do { const int blk_ = (CID) >> 3, h_ = (CID) & 7, b_ = blk_ >> 7, ch_ = blk_ & 127; \
        { const int t_ = F.tid >> 3, q8_ = F.tid & 7; const size_t tk_ = (size_t)b_ * SEQ + 64 * ch_ + t_; const bool hp_ = (64 * ch_ + t_) != 0; \
          const bf16_t* zr_ = ((bf16_t*)(F.wsb + WS_ZA)) + tk_ * ZP; const bf16_t* zq_ = zr_ - ZP; const u32x2 z0_ = (u32x2){0u, 0u}; \
          D.wc = *(const u32x2*)(zr_ + C_WLO + 4 * q8_); D.wp = hp_ ? *(const u32x2*)(zq_ + C_WLO + 4 * q8_) : z0_; D.ac = *(const u32x2*)(zr_ + C_ALO + 4 * q8_); D.ap = hp_ ? *(const u32x2*)(zq_ + C_ALO + 4 * q8_) : z0_; \
          _Pragma("unroll") for (int k3_ = 0; k3_ < 3; ++k3_) { const int col_ = 12 * q8_ + 4 * k3_; D.gc[k3_] = *(const u32x2*)(zr_ + C_GLO + col_); D.gp[k3_] = hp_ ? *(const u32x2*)(zq_ + C_GLO + col_) : z0_; } } \
        { const int hj_ = h_ * 64 + lane; const size_t tok0_ = (size_t)b_ * SEQ + 64 * ch_ + 8 * w; const bool hp_ = (ch_ != 0) || (w != 0); const bf16_t* za_ = (bf16_t*)(F.wsb + WS_ZA); \
          D.rz[0] = hp_ ? za_[(tok0_ - 1) * ZP + C_R + hj_] : (bf16_t)0; D.kz[0] = hp_ ? za_[(tok0_ - 1) * ZP + C_K + hj_] : (bf16_t)0; D.vz[0] = hp_ ? za_[(tok0_ - 1) * ZP + C_V + hj_] : (bf16_t)0; \
          _Pragma("unroll") for (int s_ = 0; s_ < 8; ++s_) { const size_t tk_ = tok0_ + s_; D.rz[s_ + 1] = za_[tk_ * ZP + C_R + hj_]; D.kz[s_ + 1] = za_[tk_ * ZP + C_K + hj_]; D.vz[s_ + 1] = za_[tk_ * ZP + C_V + hj_]; } } } while (0)
    ChunkIn cin;
    const int hq = F.vcu & 7; unsigned* qhead = F.ctl + CW_Q_CHUNK + 64 * hq; LAS int* qslot2 = (LAS int*)(L + L_SEG + 4096);
    __syncthreads();
    if (F.tid == 0) qslot2[0] = (int)__hip_atomic_fetch_add(qhead, 1u, RLX_AGENT);
    __syncthreads();
    int blk = __builtin_amdgcn_readfirstlane(qslot2[0]); int nticket = 0;
    for (int it_ = 0;; ++it_) {
        if (blk >= 512) break;
        int h = hq; asm volatile("" : "+s"(h));
        CHUNK_LOAD(cin, blk * 8 + h);
        const int b = blk >> 7, chunk = blk & 127, chain = b * 8 + h;
        unsigned char* CB = CH + ((size_t)(chain * 128 + chunk)) * CH_BYTES;
        bf16x8 hbW[2], hbA[2], hbG[2][3]; float hw0[2], ha0[2];
        constexpr int L_TW = 3 * SLOT, L_TA = L_TW + 64 * 80, L_TG = L_TA + 64 * 80, L_LWS = 9 * SLOT, L_AAS = L_LWS + 64 * 65 * 4;
        {
            const int t = F.tid >> 3, q8 = F.tid & 7;
            { const u32x2 cw = cin.wc, pw = cin.wp; const f32x4 mu = *(const f32x4*)(F.A.in[(I_MUW) + F.z] + 4 * q8);
              float v[4]; const float c4[4] = {bflo(cw.x), bfhi(cw.x), bflo(cw.y), bfhi(cw.y)}, p4[4] = {bflo(pw.x), bfhi(pw.x), bflo(pw.y), bfhi(pw.y)};
#pragma unroll
              for (int e = 0; e < 4; ++e) { const float x_ = c4[e] + (p4[e] - c4[e]) * mu[e]; v[e] = 1.0f - 2.0f * frcp(1.0f + __expf(2.0f * x_)); }
              *(LAS u32x2*)(L + L_TW + t * 80 + 8 * q8) = (u32x2){cvtpk(v[0], v[1]), cvtpk(v[2], v[3])}; }
            { const u32x2 cw = cin.ac, pw = cin.ap; const f32x4 mu = *(const f32x4*)(F.A.in[(I_MUA) + F.z] + 4 * q8);
              float v[4]; const float c4[4] = {bflo(cw.x), bfhi(cw.x), bflo(cw.y), bfhi(cw.y)}, p4[4] = {bflo(pw.x), bfhi(pw.x), bflo(pw.y), bfhi(pw.y)};
#pragma unroll
              for (int e = 0; e < 4; ++e) v[e] = c4[e] + (p4[e] - c4[e]) * mu[e];
              *(LAS u32x2*)(L + L_TA + t * 80 + 8 * q8) = (u32x2){cvtpk(v[0], v[1]), cvtpk(v[2], v[3])}; }
#pragma unroll
            for (int k3 = 0; k3 < 3; ++k3) { const int col = 12 * q8 + 4 * k3; const u32x2 cw = cin.gc[k3], pw = cin.gp[k3]; const f32x4 mu = *(const f32x4*)(F.A.in[(I_MUG) + F.z] + col);
              float v[4]; const float c4[4] = {bflo(cw.x), bfhi(cw.x), bflo(cw.y), bfhi(cw.y)}, p4[4] = {bflo(pw.x), bfhi(pw.x), bflo(pw.y), bfhi(pw.y)};
#pragma unroll
              for (int e = 0; e < 4; ++e) v[e] = sigmoidf_(c4[e] + (p4[e] - c4[e]) * mu[e]);
              *(LAS u32x2*)(L + L_TG + t * 208 + 2 * col) = (u32x2){cvtpk(v[0], v[1]), cvtpk(v[2], v[3])}; }
#pragma unroll
        for (int q = 0; q < 2; ++q) { const int hc = h * 64 + 16 * (2 * half + q) + c;
        hbW[q] = *(const bf16x8*)(((bf16_t*)(F.wsb + WS_W2W)) + hc * 32 + 8 * g); hbA[q] = *(const bf16x8*)(((bf16_t*)(F.wsb + WS_W2A)) + hc * 32 + 8 * g);
#pragma unroll
        for (int ks = 0; ks < 3; ++ks) hbG[q][ks] = *(const bf16x8*)(((bf16_t*)(F.wsb + WS_WGT)) + hc * 96 + 32 * ks + 8 * g);
        hw0[q] = F.A.in[(I_W0) + F.z][hc]; ha0[q] = F.A.in[(I_A0) + F.z][hc]; }
            LDS_BAR();
        }
        {
            const bf16x8 aW = *(const LAS bf16x8*)(L + L_TW + (16 * mi + c) * 80 + 16 * g), aA = *(const LAS bf16x8*)(L + L_TA + (16 * mi + c) * 80 + 16 * g);
            bf16x8 aG[3];
#pragma unroll
            for (int ks = 0; ks < 3; ++ks) aG[ks] = *(const LAS bf16x8*)(L + L_TG + (16 * mi + c) * 208 + 64 * ks + 16 * g);
#pragma unroll
            for (int q = 0; q < 2; ++q) { const int ni = 2 * half + q, hc = h * 64 + 16 * ni + c;
                const bf16x8 bW = hbW[q], bA = hbA[q];
                const f32x4 dw = MF16(aW, bW, Z4), da = MF16(aA, bA, Z4);
                f32x4 dg = Z4;
#pragma unroll
                for (int ks = 0; ks < 3; ++ks) dg = MF16(aG[ks], hbG[q][ks], dg);
                const float w0c = hw0[q], a0c = ha0[q];
                bf16_t* gp = ((bf16_t*)(F.wsb + WS_XN)) + ((size_t)b * SEQ + 64 * chunk + 16 * mi + 4 * g) * 1024 + 512 + hc;
#pragma unroll
                for (int r = 0; r < 4; ++r) { const float wl = w0c + dw[r]; const float nx = -wl; const float sp = fmaxf(nx, 0.f) + __logf(1.0f + __expf(-fabsf(nx)));
                    ((LAS float*)(L + L_LWS))[(16 * mi + 4 * g + r) * 65 + 16 * ni + c] = -__expf(-sp - 0.5f) * LOG2E;
                    ((LAS float*)(L + L_AAS))[(16 * mi + 4 * g + r) * 65 + 16 * ni + c] = sigmoidf_(a0c + da[r]);
                    gp[(size_t)r * 1024] = f2bf(dg[r]); } }
            LDS_BAR();
        }
        {
            const int j = lane, seg = w, hj = h * 64 + j; const size_t tok0 = (size_t)b * SEQ + 64 * chunk + 8 * seg;
            const float mur = F.A.in[(I_MUR) + F.z][hj], muk = F.A.in[(I_MUK) + F.z][hj], muv = F.A.in[(I_MUV) + F.z][hj], kkc = F.A.in[(I_KK) + F.z][hj], kac = F.A.in[(I_KA) + F.z][hj], rkc = F.A.in[(I_RK) + F.z][hj];
            float rz[9], kz[9], vz[9], lw[8], aa[8];
            rz[0] = bf2f(cin.rz[0]); kz[0] = bf2f(cin.kz[0]); vz[0] = bf2f(cin.vz[0]);
#pragma unroll
            for (int s = 0; s < 8; ++s) { rz[s + 1] = bf2f(cin.rz[s + 1]); kz[s + 1] = bf2f(cin.kz[s + 1]); vz[s + 1] = bf2f(cin.vz[s + 1]);
                lw[s] = ((LAS float*)(L + L_LWS))[(8 * seg + s) * 65 + j]; aa[s] = ((LAS float*)(L + L_AAS))[(8 * seg + s) * 65 + j]; }
            float cum[8], kk[8], kh[8], rs[8]; float run = 0.f; unsigned vpk[4];
#pragma unroll
            for (int s = 0; s < 8; ++s) { run += lw[s]; cum[s] = run;
                rs[s] = rz[s + 1] + (rz[s] - rz[s + 1]) * mur; const float ks = kz[s + 1] + (kz[s] - kz[s + 1]) * muk;
                const float kq = ks * kkc; const float ssq = dpp_sum(kq * kq); kk[s] = kq * frcp(fmaxf(sqrtf(ssq), 1e-12f));
                kh[s] = ks * (1.0f + (aa[s] - 1.0f) * kac);
                const float bsum = dpp_sum(rs[s] * kh[s] * rkc); if (lane == 0) ((float*)(F.wsb + WS_BON))[(tok0 + s) * 8 + h] = bsum; }
#pragma unroll
            for (int s = 0; s < 4; ++s) { const float v0 = vz[2 * s + 1] + (vz[2 * s] - vz[2 * s + 1]) * muv, v1 = vz[2 * s + 2] + (vz[2 * s + 1] - vz[2 * s + 2]) * muv; vpk[s] = cvtpk(v0, v1); }
            *(LAS u32x4*)(L + L_VC + nsa_off(j, seg)) = (u32x4){vpk[0], vpk[1], vpk[2], vpk[3]};
            ((LAS float*)(L + L_SEG))[seg * 64 + j] = run;
            LDS_BAR();
            float off = 0.f, tot = 0.f;
#pragma unroll
            for (int s = 0; s < 8; ++s) { const float x = ((LAS float*)(L + L_SEG))[s * 64 + j]; tot += x; off += (s < seg) ? x : 0.f; }
            if (seg == 0) ((LAS float*)(L + L_GC))[j] = fast_exp2(tot);
            float at[8], bh[8], kc[8];
#pragma unroll
            for (int s = 0; s < 8; ++s) { const float cs = cum[s] + off; const float ep = fast_exp2(cs), en = fast_exp2(-cs), er = fast_exp2(tot - cs); const int t = 8 * seg + s;
                const float beta = kk[s] * aa[s]; at[s] = kk[s] * fast_exp2(cs - lw[s]); bh[s] = beta * er; kc[s] = kh[s] * er;
                { const int o_ = nsa_off(t, j >> 3) + 2 * (j & 7); *(LAS bf16_t*)(L + L_ATR + o_) = f2bf(at[s]); *(LAS bf16_t*)(L + L_RTR + o_) = f2bf(rs[s] * ep);
                *(LAS bf16_t*)(L + L_BTR + o_) = f2bf(beta * en); *(LAS bf16_t*)(L + L_KTR + o_) = f2bf(kh[s] * en); } }
            *(LAS u32x4*)(L + L_XA + nsa_off(j, seg)) = (u32x4){cvtpk(at[0], at[1]), cvtpk(at[2], at[3]), cvtpk(at[4], at[5]), cvtpk(at[6], at[7])};
            *(LAS u32x4*)(L + L_BHC + nsa_off(j, seg)) = (u32x4){cvtpk(bh[0], bh[1]), cvtpk(bh[2], bh[3]), cvtpk(bh[4], bh[5]), cvtpk(bh[6], bh[7])};
            *(LAS u32x4*)(L + L_KCC + nsa_off(j, seg)) = (u32x4){cvtpk(kc[0], kc[1]), cvtpk(kc[2], kc[3]), cvtpk(kc[4], kc[5]), cvtpk(kc[6], kc[7])};
            LDS_BAR();
        }
        if (F.tid == 0) nticket = (int)__hip_atomic_fetch_add(qhead, 1u, RLX_AGENT);
        f32x4 X[4], Mk[2];
        {
            bf16x8 aA[2]; aA[0] = ldfrag(L, L_ATR, 16 * mi, 0, c, g); aA[1] = ldfrag(L, L_ATR, 16 * mi, 1, c, g);
#pragma unroll
            for (int q = 0; q < 4; ++q) {
                const int bsrc = half ? L_KTR : L_BTR;
                f32x4 t = MF16(aA[0], ldfrag(L, bsrc, 16 * q, 0, c, g), Z4); t = MF16(aA[1], ldfrag(L, bsrc, 16 * q, 1, c, g), t);
#pragma unroll
                for (int r = 0; r < 4; ++r) t[r] = ((16 * q + c) < (16 * mi + 4 * g + r)) ? t[r] : 0.f;
                if (half == 0) { const f32x4 p0 = -t; store_T(L, L_PAC, 16 * mi, 16 * q, p0, c, g); store_R(L, L_PAR, 16 * mi, 16 * q, p0, c, g);
                    X[q] = ld_c4(L, L_XA, 16 * q + c, 16 * mi + 4 * g); }
                else { X[q] = t; store_T(L, L_XA + 8192, 16 * mi, 16 * q, t, c, g); }
            }
            bf16x8 aB[2], aK[2]; aB[0] = ldfrag(L, L_BTR, 16 * mi, 0, c, g); aB[1] = ldfrag(L, L_BTR, 16 * mi, 1, c, g); aK[0] = ldfrag(L, L_KTR, 16 * mi, 0, c, g); aK[1] = ldfrag(L, L_KTR, 16 * mi, 1, c, g);
#pragma unroll
            for (int q = 0; q < 2; ++q) { const int n0 = 16 * (2 * half + q); const bf16x8 bR0 = ldfrag(L, L_RTR, n0, 0, c, g), bR1 = ldfrag(L, L_RTR, n0, 1, c, g);
                f32x4 rb = MF16(aB[0], bR0, Z4); rb = MF16(aB[1], bR1, rb); f32x4 rk = MF16(aK[0], bR0, Z4); rk = MF16(aK[1], bR1, rk);
#pragma unroll
                for (int r = 0; r < 4; ++r) { const bool keep = (16 * mi + 4 * g + r) <= (n0 + c); rb[r] = keep ? rb[r] : 0.f; rk[r] = keep ? rk[r] : 0.f; }
                store_T(L, L_MBR, 16 * mi, n0, rb, c, g); Mk[q] = rk; }
            LDS_BAR();
        }
#pragma unroll
        for (int s = 0; s < 6; ++s) {
            const int Pr = (s & 1) ? L_PBR : L_PAR, Pc = (s & 1) ? L_PBC : L_PAC, Xc = (s & 1) ? L_XB : L_XA;
            const int Prn = (s & 1) ? L_PAR : L_PBR, Pcn = (s & 1) ? L_PAC : L_PBC, Xn = (s & 1) ? L_XA : L_XB;
            const bf16x8 a0 = ldfrag(L, Pr, 16 * mi, 0, c, g), a1 = ldfrag(L, Pr, 16 * mi, 1, c, g);
#pragma unroll
            for (int q = 0; q < 4; ++q) { const int n0 = 16 * (4 * half + q); X[q] = MF16(a0, ldfrag(L, Xc, n0, 0, c, g), X[q]); X[q] = MF16(a1, ldfrag(L, Xc, n0, 1, c, g), X[q]); }
            f32x4 Pn[2];
            if (s < 5) {
#pragma unroll
                for (int q = 0; q < 2; ++q) { const int n0 = 16 * (2 * half + q); Pn[q] = MF16(a0, ldfrag(L, Pc, n0, 0, c, g), Z4); Pn[q] = MF16(a1, ldfrag(L, Pc, n0, 1, c, g), Pn[q]); }
            }
#pragma unroll
            for (int q = 0; q < 4; ++q) store_T(L, Xn, 16 * mi, 16 * (4 * half + q), (s == 5) ? -X[q] : X[q], c, g);
            if (s < 5) {
#pragma unroll
                for (int q = 0; q < 2; ++q) { store_T(L, Pcn, 16 * mi, 16 * (2 * half + q), Pn[q], c, g); store_R(L, Prn, 16 * mi, 16 * (2 * half + q), Pn[q], c, g); }
            }
            LDS_BAR();
        }
        {
            bf16x8 aN1[2], aN2[2]; aN1[0] = ldfrag(L, L_XA, 16 * mi, 0, c, g); aN1[1] = ldfrag(L, L_XA, 16 * mi, 1, c, g); aN2[0] = ldfrag(L, L_XA, 64 + 16 * mi, 0, c, g); aN2[1] = ldfrag(L, L_XA, 64 + 16 * mi, 1, c, g);
#pragma unroll
            for (int q = 0; q < 2; ++q) { const int n0 = 16 * (2 * half + q);
                const bf16x8 bM0 = ldfrag(L, L_MBR, n0, 0, c, g), bM1 = ldfrag(L, L_MBR, n0, 1, c, g), bH0 = ldfrag(L, L_BHC, n0, 0, c, g), bH1 = ldfrag(L, L_BHC, n0, 1, c, g);
                f32x4 wy = ld_c4(L, L_RTR, n0 + c, 16 * mi + 4 * g); wy = MF16(aN1[0], bM0, wy); wy = MF16(aN1[1], bM1, wy);
                { u32x2 ww; ww.x = cvtpk(wy[0], wy[1]); ww.y = cvtpk(wy[2], wy[3]); *(u32x2*)(CB + CH_WY + (((2 * half + q) * 2 + (mi >> 1)) * 64 + lane) * 16 + (mi & 1) * 8) = ww; }
                f32x4 py = Mk[q]; py = MF16(aN2[0], bM0, py); py = MF16(aN2[1], bM1, py); store_T(L, L_PAR, 16 * mi, n0, py, c, g);
                f32x4 gt = MF16(aN1[0], bH0, Z4); gt = MF16(aN1[1], bH1, gt); const float gcv = ((LAS float*)(L + L_GC))[n0 + c];
#pragma unroll
                for (int r = 0; r < 4; ++r) gt[r] += ((16 * mi + 4 * g + r) == (n0 + c)) ? gcv : 0.f;
                { u32x2 ww; ww.x = cvtpk(gt[0], gt[1]); ww.y = cvtpk(gt[2], gt[3]); *(u32x2*)(CB + CH_GT + (((2 * half + q) * 2 + (mi >> 1)) * 64 + lane) * 16 + (mi & 1) * 8) = ww; }
                f32x4 zh = ld_c4(L, L_KCC, n0 + c, 16 * mi + 4 * g); zh = MF16(aN2[0], bH0, zh); zh = MF16(aN2[1], bH1, zh); store_T(L, L_PAC, 16 * mi, n0, zh, c, g); }
            LDS_BAR();
        }
        {
            const bf16x8 aZ0 = ldfrag(L, L_PAC, 16 * mi, 0, c, g), aZ1 = ldfrag(L, L_PAC, 16 * mi, 1, c, g), aP0 = ldfrag(L, L_PAR, 16 * mi, 0, c, g), aP1 = ldfrag(L, L_PAR, 16 * mi, 1, c, g);
#pragma unroll
            for (int q = 0; q < 2; ++q) { const int ni = 2 * half + q; const bf16x8 bV0 = ldfrag(L, L_VC, 16 * ni, 0, c, g), bV1 = ldfrag(L, L_VC, 16 * ni, 1, c, g);
                f32x4 ht = MF16(aZ0, bV0, Z4); ht = MF16(aZ1, bV1, ht); f32x4 y0 = MF16(aP0, bV0, Z4); y0 = MF16(aP1, bV1, y0);
                u32x2 w1; w1.x = cvtpk(ht[0], ht[1]); w1.y = cvtpk(ht[2], ht[3]); *(u32x2*)(CB + CH_HT + ((mi * 4 + ni) * 64 + lane) * 8) = w1;
                u32x2 w2; w2.x = cvtpk(y0[0], y0[1]); w2.y = cvtpk(y0[2], y0[3]); *(u32x2*)(CB + CH_Y0 + ((mi * 4 + ni) * 64 + lane) * 8) = w2; }
            if (F.tid == 0) qslot2[(it_ + 1) & 1] = nticket;
            LDS_BAR();
        }
        blk = __builtin_amdgcn_readfirstlane(qslot2[(it_ + 1) & 1]);
    }
#undef CHUNK_LOAD
}
constexpr int SC_SLOT = 32768, SC_CTR = LDS_BYTES - 64;
__device__ __forceinline__ void rwkv_scan_serial(Frame& F0, const unsigned char* CH, int chain) {
    PHASE_FRAME(F, F0);
    const int lane = F.lane, w = F.wave, c = lane & 15, g = lane >> 4, b = chain >> 3, h = chain & 7;
    LAS unsigned char* L = F.lds; LAS unsigned* rdy = (LAS unsigned*)(L + SC_CTR); LAS unsigned* dne = rdy + 4;
    if (F.tid < 8) rdy[F.tid] = 0u;
    LDS_BAR();
    const GAS unsigned char* CB0 = (const GAS unsigned char*)CH + (size_t)chain * 128 * CH_BYTES;
    if (w >= 4) {
        const int j = w - 4; const GAS unsigned char* src = CB0 + j * 8192 + lane * 16;
#define SC_ISSUE(K) do { const int sl_ = (K) & 3; _Pragma("unroll") for (int i_ = 0; i_ < 8; ++i_) \
            __builtin_amdgcn_global_load_lds((const GAS unsigned*)(src + (size_t)(K) * CH_BYTES + i_ * 1024), (LAS unsigned*)(L + sl_ * SC_SLOT + j * 8192 + i_ * 1024), 16, 0, 0); } while (0)
        SC_ISSUE(0); SC_ISSUE(1); SC_ISSUE(2);
#pragma unroll 1
        for (int k = 3; k < 128; ++k) {
            if (k >= 4) LDS_SPIN_GE(dne + (k & 3), 4u * (unsigned)(k >> 2));
            SC_ISSUE(k);
            asm volatile("s_waitcnt vmcnt(24)" ::: "memory"); LDS_SIGNAL(lane, rdy + ((k - 3) & 3));
        }
        asm volatile("s_waitcnt vmcnt(16)" ::: "memory"); LDS_SIGNAL(lane, rdy + (125 & 3));
        asm volatile("s_waitcnt vmcnt(8)" ::: "memory"); LDS_SIGNAL(lane, rdy + (126 & 3));
        asm volatile("s_waitcnt vmcnt(0)" ::: "memory"); LDS_SIGNAL(lane, rdy + (127 & 3));
#undef SC_ISSUE
    } else {
        const int ni = w;
        f32x4 S[4];
#pragma unroll
        for (int m = 0; m < 4; ++m) S[m] = (f32x4){0.f, 0.f, 0.f, 0.f};
#pragma unroll 1
        for (int chunk = 0; chunk < 128; ++chunk) {
            bf16x8 bh[2], bl[2];
#pragma unroll
            for (int ks = 0; ks < 2; ++ks) { u32x4 hw, lwv; const f32x4 s0 = S[2 * ks], s1 = S[2 * ks + 1];
                hw.x = cvtpk(s0[0], s0[1]); hw.y = cvtpk(s0[2], s0[3]); hw.z = cvtpk(s1[0], s1[1]); hw.w = cvtpk(s1[2], s1[3]);
                lwv.x = cvtpk(s0[0] - bflo(hw.x), s0[1] - bfhi(hw.x)); lwv.y = cvtpk(s0[2] - bflo(hw.y), s0[3] - bfhi(hw.y)); lwv.z = cvtpk(s1[0] - bflo(hw.z), s1[1] - bfhi(hw.z)); lwv.w = cvtpk(s1[2] - bflo(hw.w), s1[3] - bfhi(hw.w));
                bh[ks] = __builtin_bit_cast(bf16x8, hw); bl[ks] = __builtin_bit_cast(bf16x8, lwv); }
            const int sl = chunk & 3; LAS unsigned char* CBL = L + sl * SC_SLOT;
            LDS_SPIN_GE(rdy + sl, 4u * (unsigned)((chunk >> 2) + 1));
            u32x4 gt[4][2], wy[4][2]; u32x2 ht[4], y0[4];
#pragma unroll
            for (int m = 0; m < 4; ++m) {
#pragma unroll
                for (int ks = 0; ks < 2; ++ks) { const int off = ((m * 2 + ks) * 64 + lane) * 16; gt[m][ks] = *(const LAS u32x4*)(CBL + CH_GT + off); wy[m][ks] = *(const LAS u32x4*)(CBL + CH_WY + off); }
                ht[m] = *(const LAS u32x2*)(CBL + CH_HT + ((m * 4 + ni) * 64 + lane) * 8); y0[m] = *(const LAS u32x2*)(CBL + CH_Y0 + ((m * 4 + ni) * 64 + lane) * 8); }
            LDS_SIGNAL(lane, dne + sl);
            const size_t tokb = (size_t)b * SEQ + 64 * chunk;
#pragma unroll
            for (int m = 0; m < 4; ++m) {
                f32x4 ns = (f32x4){bflo(ht[m].x), bfhi(ht[m].x), bflo(ht[m].y), bfhi(ht[m].y)};
                f32x4 y = (f32x4){bflo(y0[m].x), bfhi(y0[m].x), bflo(y0[m].y), bfhi(y0[m].y)};
#pragma unroll
                for (int ks = 0; ks < 2; ++ks) { const bf16x8 ag = __builtin_bit_cast(bf16x8, gt[m][ks]); const bf16x8 aw = __builtin_bit_cast(bf16x8, wy[m][ks]);
                    ns = MF16(ag, bh[ks], ns); ns = MF16(ag, bl[ks], ns); y = MF16(aw, bh[ks], y); y = MF16(aw, bl[ks], y); }
                bf16_t* yp = ((bf16_t*)(F.wsb + WS_AA)) + (tokb + 16 * m + 4 * g) * 512 + h * 64 + 16 * ni + c;
#pragma unroll
                for (int r = 0; r < 4; ++r) yp[(size_t)r * 512] = f2bf(y[r]);
                S[m] = ns;
            }
        }
    }
    asm volatile("s_waitcnt vmcnt(0)" ::: "memory");
    __syncthreads();
    if (F.tid == 0) { __builtin_amdgcn_fence(__ATOMIC_RELEASE, "agent"); asm volatile("s_waitcnt vmcnt(0)" ::: "memory"); (void)__hip_atomic_fetch_add(F.ctl + CW_SCAN_DONE, 1u, RLX_AGENT); }
}

__device__ __forceinline__ void rwkv_post(Frame& F0) {
    PHASE_FRAME(F, F0);
    const int lane = F.lane, c0 = lane * 8;
    bf16_t* OAB = ((bf16_t*)(F.wsb + WS_XN));
    LAS int* slot = (LAS int*)(F.lds + LDS_BYTES - 256) + 8;
    __syncthreads();
    if (F.tid == 0) {
        unsigned sp = 0u;
        while (__hip_atomic_load(F.ctl + CW_SCAN_DONE, __ATOMIC_RELAXED, __HIP_MEMORY_SCOPE_AGENT) < 32u) { __builtin_amdgcn_s_sleep(8); if (++sp > (1u << 24)) break; }
        __builtin_amdgcn_fence(__ATOMIC_ACQUIRE, "agent");
        slot[0] = (int)__hip_atomic_fetch_add(F.ctl + CW_Q_POST, 1u, RLX_AGENT);
    }
    __syncthreads();
    int par = 0;
    for (;;) {
        const int item = __builtin_amdgcn_readfirstlane(slot[par]);
        if (item >= 512) break;
        int nxt = 0; if (F.tid == 0) nxt = (int)__hip_atomic_fetch_add(F.ctl + CW_Q_POST, 1u, RLX_AGENT);
    for (int k2 = 0; k2 < 2; ++k2) { const int it = item * 16 + k2 * 8 + F.wave;
        const int t0 = it * 4;
        float muv[8], lw_[8], lb_[8];
#pragma unroll
        for (int e = 0; e < 8; ++e) { muv[e] = F.A.in[(I_MUV) + F.z][c0 + e]; lw_[e] = F.A.in[(I_LNXW) + F.z][c0 + e]; lb_[e] = F.A.in[(I_LNXB) + F.z][c0 + e]; }
#pragma unroll
        for (int q = 0; q < 4; ++q) { const int t = t0 + q; const bool hp = (t & (SEQ - 1)) != 0; const size_t zr = (size_t)t * ZP, zq = (size_t)(t - 1) * ZP;
            const u32x4 yw = *(const u32x4*)(((bf16_t*)(F.wsb + WS_AA)) + (size_t)t * 512 + c0);
            const u32x4 gw4 = *(const u32x4*)(OAB + (size_t)t * 1024 + 512 + c0);
            const u32x4 vz = *(const u32x4*)(((bf16_t*)(F.wsb + WS_ZA)) + zr + C_V + c0);
            u32x4 vp = (u32x4){0u, 0u, 0u, 0u}; if (hp) vp = *(const u32x4*)(((bf16_t*)(F.wsb + WS_ZA)) + zq + C_V + c0);
            const float bs = ((float*)(F.wsb + WS_BON))[(size_t)t * 8 + (lane >> 3)];
            float y[8], vs[8]; float sy = 0.f;
#pragma unroll
            for (int e = 0; e < 8; ++e) {
#define UNP(W) ((e & 1) ? bfhi(W[e >> 1]) : bflo(W[e >> 1]))
                y[e] = UNP(yw); sy += y[e]; const float v0 = UNP(vz), v1 = UNP(vp);
#undef UNP
                vs[e] = v0 + (v1 - v0) * muv[e]; }
            sy += __shfl_xor(sy, 1); sy += __shfl_xor(sy, 2); sy += __shfl_xor(sy, 4);
            const float mean = sy * (1.f / 64.f); float sv = 0.f;
#pragma unroll
            for (int e = 0; e < 8; ++e) { const float d = y[e] - mean; sv += d * d; }
            sv += __shfl_xor(sv, 1); sv += __shfl_xor(sv, 2); sv += __shfl_xor(sv, 4);
            const float rstd = __builtin_amdgcn_rsqf(sv * (1.f / 64.f) + 64e-5f); float o[8];
#pragma unroll
            for (int e = 0; e < 8; ++e) { const unsigned gwv = gw4[e >> 1]; o[e] = (((y[e] - mean) * rstd) * lw_[e] + lb_[e] + bs * vs[e]) * ((e & 1) ? bfhi(gwv) : bflo(gwv)); }
            *(u32x4*)(OAB + (size_t)t * 1024 + 512 + c0) = (u32x4){cvtpk(o[0], o[1]), cvtpk(o[2], o[3]), cvtpk(o[4], o[5]), cvtpk(o[6], o[7])};
        }
    }
        if (F.tid == 0) slot[par ^ 1] = nxt;
        __syncthreads();
        par ^= 1;
    }
}

struct AttnSt { float m, l; f32x4 o[4]; };
__device__ __forceinline__ void attn_init(AttnSt& s) { s.m = -1e30f; s.l = 0.f;
#pragma unroll
    for (int d = 0; d < 4; ++d) s.o[d] = (f32x4){0.f, 0.f, 0.f, 0.f}; }
__device__ __forceinline__ void qk_block(f32x4 (&s)[4], const bf16x8 q0, const bf16x8 q1, const bf16_t* Kb, int kp, int c, int g) {
#pragma unroll
    for (int kt = 0; kt < 4; ++kt) { const bf16_t* kr = Kb + (size_t)(16 * kt + c) * kp + 8 * g;
        const bf16x8 k0 = *(const bf16x8*)kr, k1 = *(const bf16x8*)(kr + 32);
        f32x4 z = (f32x4){0.f, 0.f, 0.f, 0.f};
        z = __builtin_amdgcn_mfma_f32_16x16x32_bf16(k0, q0, z, 0, 0, 0); s[kt] = __builtin_amdgcn_mfma_f32_16x16x32_bf16(k1, q1, z, 0, 0, 0); }
}
__device__ __forceinline__ void pv_block(f32x4 (&o)[4], const f32x4 (&p)[4], const bf16_t* VTb, int vtp, int c, int g) {
#pragma unroll
    for (int ks = 0; ks < 2; ++ks) {
        u32x4 pw; pw.x = cvtpk(p[2 * ks][0], p[2 * ks][1]); pw.y = cvtpk(p[2 * ks][2], p[2 * ks][3]); pw.z = cvtpk(p[2 * ks + 1][0], p[2 * ks + 1][1]); pw.w = cvtpk(p[2 * ks + 1][2], p[2 * ks + 1][3]);
        const bf16x8 pb = __builtin_bit_cast(bf16x8, pw);
#pragma unroll
        for (int dt = 0; dt < 4; ++dt) { const bf16_t* vr = VTb + (size_t)(16 * dt + c) * vtp + 32 * ks + 4 * g;
            const u32x2 va = *(const u32x2*)vr, vb = *(const u32x2*)(vr + 16);
            const bf16x8 a = __builtin_bit_cast(bf16x8, (u32x4){va.x, va.y, vb.x, vb.y});
            o[dt] = __builtin_amdgcn_mfma_f32_16x16x32_bf16(a, pb, o[dt], 0, 0, 0); }
    }
}
template <class Valid>
__device__ __forceinline__ void attn_block(AttnSt& st, const bf16x8 q0, const bf16x8 q1, const bf16_t* Kb, int kp, const bf16_t* VTb, int vtp, int c, int g, const Valid& valid) {
    f32x4 s[4]; qk_block(s, q0, q1, Kb, kp, c, g);
    float mx = -1e30f;
#pragma unroll
    for (int kt = 0; kt < 4; ++kt)
#pragma unroll
        for (int r = 0; r < 4; ++r) { const bool v = valid(16 * kt + 4 * g + r); s[kt][r] = v ? s[kt][r] : -1e30f; mx = fmaxf(mx, s[kt][r]); }
    mx = fmaxf(mx, __shfl_xor(mx, 16)); mx = fmaxf(mx, __shfl_xor(mx, 32));
    const float mn = fmaxf(st.m, mx), alpha = fast_exp2(st.m - mn); float ps = 0.f;
#pragma unroll
    for (int kt = 0; kt < 4; ++kt)
#pragma unroll
        for (int r = 0; r < 4; ++r) { const float p = (s[kt][r] > -1e29f) ? fast_exp2(s[kt][r] - mn) : 0.f; s[kt][r] = p; ps += p; }
    st.l = st.l * alpha + ps; st.m = mn;
#pragma unroll
    for (int d = 0; d < 4; ++d) st.o[d] = st.o[d] * alpha;
    pv_block(st.o, s, VTb, vtp, c, g);
}

constexpr int NSLOT = 8192, NK_OFF = 0, NV_OFF = 2 * NSLOT, NI_OFF = 4 * NSLOT, NACC_OFF = NI_OFF + 65536, NQ_OFF = LDS_BYTES - 256;

__device__ __forceinline__ void qk_block_lds(f32x4 (&s)[4], const bf16x8 q0, const bf16x8 q1, LAS unsigned char* Kb, int c, int g) {
#pragma unroll
    for (int kt = 0; kt < 4; ++kt) {
        const bf16x8 k0 = *(const LAS bf16x8*)(Kb + nsa_off(16 * kt + c, g)), k1 = *(const LAS bf16x8*)(Kb + nsa_off(16 * kt + c, 4 + g));
        f32x4 z = (f32x4){0.f, 0.f, 0.f, 0.f};
        z = __builtin_amdgcn_mfma_f32_16x16x32_bf16(k0, q0, z, 0, 0, 0); s[kt] = __builtin_amdgcn_mfma_f32_16x16x32_bf16(k1, q1, z, 0, 0, 0); }
}
__device__ __forceinline__ void pv_block_lds(f32x4 (&o)[4], const f32x4 (&p)[4], LAS unsigned char* Vb, int c, int g) {
#pragma unroll
    for (int ks = 0; ks < 2; ++ks) {
        u32x4 pw; pw.x = cvtpk(p[2 * ks][0], p[2 * ks][1]); pw.y = cvtpk(p[2 * ks][2], p[2 * ks][3]); pw.z = cvtpk(p[2 * ks + 1][0], p[2 * ks + 1][1]); pw.w = cvtpk(p[2 * ks + 1][2], p[2 * ks + 1][3]);
        const bf16x8 pb = __builtin_bit_cast(bf16x8, pw);
#pragma unroll
        for (int dt = 0; dt < 4; ++dt) { const bf16x8 a = *(const LAS bf16x8*)(Vb + nsa_off(16 * dt + c, 4 * ks + g));
            o[dt] = __builtin_amdgcn_mfma_f32_16x16x32_bf16(a, pb, o[dt], 0, 0, 0); }
    }
}
__device__ __forceinline__ int fbits(float x) { return __builtin_bit_cast(int, x); }
template <bool SAFE, bool MASKED, bool PV, class VA_, class VB_>
__device__ __forceinline__ void attn_block2g(AttnSt& sA, AttnSt& sB, const bf16x8 qa0, const bf16x8 qa1, const bf16x8 qb0, const bf16x8 qb1, LAS unsigned char* Kb, LAS unsigned char* Vb, int c, int g,
                                             bool needA, bool needB, bool doA, bool doB, const VA_& validA, const VB_& validB) {
    f32x4 sa[4], sb[4]; const float nma = needA ? (SAFE ? -sA.m : 0.f) : -1e30f, nmb = needB ? (SAFE ? -sB.m : 0.f) : -1e30f; const f32x4 cia = (f32x4){nma, nma, nma, nma}, cib = (f32x4){nmb, nmb, nmb, nmb};
#pragma unroll
    for (int kt = 0; kt < 4; ++kt) {
        const bf16x8 k0 = *(const LAS bf16x8*)(Kb + nsa_off(16 * kt + c, g)), k1 = *(const LAS bf16x8*)(Kb + nsa_off(16 * kt + c, 4 + g));
        sa[kt] = __builtin_amdgcn_mfma_f32_16x16x32_bf16(k0, qa0, cia, 0, 0, 0); sb[kt] = __builtin_amdgcn_mfma_f32_16x16x32_bf16(k0, qb0, cib, 0, 0, 0);
        sa[kt] = __builtin_amdgcn_mfma_f32_16x16x32_bf16(k1, qa1, sa[kt], 0, 0, 0); sb[kt] = __builtin_amdgcn_mfma_f32_16x16x32_bf16(k1, qb1, sb[kt], 0, 0, 0); }
    if (MASKED) {
#pragma unroll
        for (int kt = 0; kt < 4; ++kt)
#pragma unroll
            for (int r = 0; r < 4; ++r) { sa[kt][r] = validA(16 * kt + 4 * g + r) ? sa[kt][r] : -1e30f; sb[kt][r] = validB(16 * kt + 4 * g + r) ? sb[kt][r] : -1e30f; }
    }
if (SAFE) {
#define IB_(x) fbits(x)
    int ima = max(max(IB_(sa[0][0]), IB_(sa[0][1])), max(IB_(sa[0][2]), IB_(sa[0][3]))), imb = max(max(IB_(sb[0][0]), IB_(sb[0][1])), max(IB_(sb[0][2]), IB_(sb[0][3])));
#pragma unroll
    for (int kt = 1; kt < 4; ++kt) { ima = max(ima, max(max(IB_(sa[kt][0]), IB_(sa[kt][1])), max(IB_(sa[kt][2]), IB_(sa[kt][3])))); imb = max(imb, max(max(IB_(sb[kt][0]), IB_(sb[kt][1])), max(IB_(sb[kt][2]), IB_(sb[kt][3])))); }
#undef IB_
    if (__builtin_expect(__ballot((ima > 0x41000000) || (imb > 0x41000000)) != 0ull, 0)) {
        float mxa = (ima > 0x41000000) ? __builtin_bit_cast(float, ima) : 0.f, mxb = (imb > 0x41000000) ? __builtin_bit_cast(float, imb) : 0.f;
        mxa = fmaxf(mxa, __shfl_xor(mxa, 16)); mxa = fmaxf(mxa, __shfl_xor(mxa, 32)); mxb = fmaxf(mxb, __shfl_xor(mxb, 16)); mxb = fmaxf(mxb, __shfl_xor(mxb, 32));
        const float da = (mxa > 8.0f) ? mxa : 0.f, db = (mxb > 8.0f) ? mxb : 0.f; const float ala = fast_exp2(-da), alb = fast_exp2(-db);
        sA.m += da; sA.l *= ala; sB.m += db; sB.l *= alb;
#pragma unroll
        for (int kt = 0; kt < 4; ++kt) { sa[kt] = sa[kt] - da; sb[kt] = sb[kt] - db; }
        if (PV) {
#pragma unroll
            for (int dd = 0; dd < 4; ++dd) { sA.o[dd] = sA.o[dd] * ala; sB.o[dd] = sB.o[dd] * alb; } }
    }
    }
    float psa = 0.f, psb = 0.f;
#pragma unroll
    for (int kt = 0; kt < 4; ++kt)
#pragma unroll
        for (int r = 0; r < 4; ++r) { sa[kt][r] = fast_exp2(sa[kt][r]); psa += sa[kt][r]; sb[kt][r] = fast_exp2(sb[kt][r]); psb += sb[kt][r]; }
    sA.l += psa; sB.l += psb;
    if (PV) {
#pragma unroll
        for (int ks = 0; ks < 2; ++ks) {
            u32x4 pa, pb2; pa.x = cvtpk(sa[2 * ks][0], sa[2 * ks][1]); pa.y = cvtpk(sa[2 * ks][2], sa[2 * ks][3]); pa.z = cvtpk(sa[2 * ks + 1][0], sa[2 * ks + 1][1]); pa.w = cvtpk(sa[2 * ks + 1][2], sa[2 * ks + 1][3]);
            pb2.x = cvtpk(sb[2 * ks][0], sb[2 * ks][1]); pb2.y = cvtpk(sb[2 * ks][2], sb[2 * ks][3]); pb2.z = cvtpk(sb[2 * ks + 1][0], sb[2 * ks + 1][1]); pb2.w = cvtpk(sb[2 * ks + 1][2], sb[2 * ks + 1][3]);
            const bf16x8 fa = __builtin_bit_cast(bf16x8, pa), fb = __builtin_bit_cast(bf16x8, pb2);
#pragma unroll
            for (int dt = 0; dt < 4; ++dt) { const bf16x8 a = *(const LAS bf16x8*)(Vb + nsa_off(16 * dt + c, 4 * ks + g));
                sA.o[dt] = __builtin_amdgcn_mfma_f32_16x16x32_bf16(a, fa, sA.o[dt], 0, 0, 0);
                sB.o[dt] = __builtin_amdgcn_mfma_f32_16x16x32_bf16(a, fb, sB.o[dt], 0, 0, 0); }
        }
    }
}
#define NSA_BLOCK_LOOP(F, Kg_, kp_, Vg_, vp_, hasV_, lo_, hi_, ...) do { \
    const int kb_lo_ = (lo_), kb_hi_ = (hi_); const bool hasV__ = (hasV_); \
    if (kb_hi_ >= kb_lo_) { \
    LAS unsigned char* L_ = F.lds; const int row_ = F.tid >> 3, ch_ = F.tid & 7; const int koff_ = nsa_off(row_, ch_); \
    const unsigned kpp_ = (kp_), vpp_ = (vp_); const unsigned vbs_ = ((vpp_ == 64u) ? 4096u : 64u) * 2u;        \
    const unsigned kpt_ = (unsigned)(Kg_) + ((64u * kb_lo_ + row_) * kpp_ + 8u * ch_) * 2u, vpt_ = (unsigned)(Vg_) + (row_ * vpp_ + 8u * ch_) * 2u + vbs_ * kb_lo_; const unsigned kst_ = 64u * kpp_ * 2u;        \
    u32x4 k0r_, v0r_ = (u32x4){0u, 0u, 0u, 0u}, k1r_ = (u32x4){0u, 0u, 0u, 0u}, v1r_ = (u32x4){0u, 0u, 0u, 0u}; \
    NSA_BL_LOAD(k0r_, v0r_, kb_lo_); if (kb_lo_ + 1 <= kb_hi_) NSA_BL_LOAD(k1r_, v1r_, kb_lo_ + 1); \
    NSA_BL_WRITE(k0r_, v0r_, 0); \
    LDS_BAR(); \
    for (int kb_ = kb_lo_; kb_ <= kb_hi_; kb_ += 2) { \
        if (kb_ + 2 <= kb_hi_) NSA_BL_LOAD(k0r_, v0r_, kb_ + 2); \
        { const int kb = kb_; LAS unsigned char* Kb = L_ + NK_OFF; LAS unsigned char* Vb = L_ + NV_OFF; __VA_ARGS__ } \
        if (kb_ + 1 <= kb_hi_) NSA_BL_WRITE(k1r_, v1r_, 1); \
        LDS_BAR(); \
        if (kb_ + 1 > kb_hi_) break; \
        if (kb_ + 3 <= kb_hi_) NSA_BL_LOAD(k1r_, v1r_, kb_ + 3); \
        { const int kb = kb_ + 1; LAS unsigned char* Kb = L_ + NK_OFF + NSLOT; LAS unsigned char* Vb = L_ + NV_OFF + NSLOT; __VA_ARGS__ } \
        if (kb_ + 2 <= kb_hi_) NSA_BL_WRITE(k0r_, v0r_, 0); \
        LDS_BAR(); \
    } } } while (0)
__device__ __forceinline__ void attn_block1g(AttnSt& st, const bf16x8 q0, const bf16x8 q1, LAS unsigned char* Kb, LAS unsigned char* Vb, int c, int g, bool need) {
    f32x4 sc[4]; const float nm = need ? 0.f : -1e30f; const f32x4 ci = (f32x4){nm, nm, nm, nm};
#pragma unroll
    for (int kt = 0; kt < 4; ++kt) {
        const bf16x8 k0 = *(const LAS bf16x8*)(Kb + nsa_off(16 * kt + c, g)), k1 = *(const LAS bf16x8*)(Kb + nsa_off(16 * kt + c, 4 + g));
        sc[kt] = __builtin_amdgcn_mfma_f32_16x16x32_bf16(k0, q0, ci, 0, 0, 0); sc[kt] = __builtin_amdgcn_mfma_f32_16x16x32_bf16(k1, q1, sc[kt], 0, 0, 0); }
    float ps = 0.f;
#pragma unroll
    for (int kt = 0; kt < 4; ++kt)
#pragma unroll
        for (int r = 0; r < 4; ++r) { sc[kt][r] = fast_exp2(sc[kt][r]); ps += sc[kt][r]; }
    st.l += ps;
#pragma unroll
    for (int ks = 0; ks < 2; ++ks) {
        u32x4 pa; pa.x = cvtpk(sc[2 * ks][0], sc[2 * ks][1]); pa.y = cvtpk(sc[2 * ks][2], sc[2 * ks][3]); pa.z = cvtpk(sc[2 * ks + 1][0], sc[2 * ks + 1][1]); pa.w = cvtpk(sc[2 * ks + 1][2], sc[2 * ks + 1][3]);
        const bf16x8 fa = __builtin_bit_cast(bf16x8, pa);
#pragma unroll
        for (int dt = 0; dt < 4; ++dt) { const bf16x8 a = *(const LAS bf16x8*)(Vb + nsa_off(16 * dt + c, 4 * ks + g)); st.o[dt] = __builtin_amdgcn_mfma_f32_16x16x32_bf16(a, fa, st.o[dt], 0, 0, 0); }
    }
}
#define NSA_BLOCK_LOOP_PEEL(F, Kg_, kp_, Vg_, vp_, lo_, hi_, MAIN, LAST) do { \
    const int kb_lo_ = (lo_), kb_hi_ = (hi_); const bool hasV__ = true; \
    if (kb_hi_ >= kb_lo_) { \
    LAS unsigned char* L_ = F.lds; const int row_ = F.tid >> 3, ch_ = F.tid & 7; const int koff_ = nsa_off(row_, ch_); \
    const unsigned kpp_ = (kp_), vpp_ = (vp_); const unsigned vbs_ = ((vpp_ == 64u) ? 4096u : 64u) * 2u; \
    const unsigned kpt_ = (unsigned)(Kg_) + ((64u * kb_lo_ + row_) * kpp_ + 8u * ch_) * 2u, vpt_ = (unsigned)(Vg_) + (row_ * vpp_ + 8u * ch_) * 2u + vbs_ * kb_lo_; const unsigned kst_ = 64u * kpp_ * 2u; \
    u32x4 k0r_, v0r_ = (u32x4){0u, 0u, 0u, 0u}, k1r_ = (u32x4){0u, 0u, 0u, 0u}, v1r_ = (u32x4){0u, 0u, 0u, 0u}; \
    NSA_BL_LOAD(k0r_, v0r_, kb_lo_); if (kb_lo_ + 1 <= kb_hi_) NSA_BL_LOAD(k1r_, v1r_, kb_lo_ + 1); \
    NSA_BL_WRITE(k0r_, v0r_, 0); \
    LDS_BAR(); \
    for (int kb_ = kb_lo_; kb_ < kb_hi_; kb_ += 2) { \
        if (kb_ + 2 <= kb_hi_) NSA_BL_LOAD(k0r_, v0r_, kb_ + 2); \
        { const int kb = kb_; LAS unsigned char* Kb = L_ + NK_OFF; LAS unsigned char* Vb = L_ + NV_OFF; MAIN } \
        NSA_BL_WRITE(k1r_, v1r_, 1); \
        LDS_BAR(); \
        if (kb_ + 1 >= kb_hi_) break; \
        if (kb_ + 3 <= kb_hi_) NSA_BL_LOAD(k1r_, v1r_, kb_ + 3); \
        { const int kb = kb_ + 1; LAS unsigned char* Kb = L_ + NK_OFF + NSLOT; LAS unsigned char* Vb = L_ + NV_OFF + NSLOT; MAIN } \
        NSA_BL_WRITE(k0r_, v0r_, 0); \
        LDS_BAR(); \
    } \
    { const int kb = kb_hi_; const int par_ = (kb_hi_ - kb_lo_) & 1; LAS unsigned char* Kb = L_ + NK_OFF + par_ * NSLOT; LAS unsigned char* Vb = L_ + NV_OFF + par_ * NSLOT; LAST } \
    LDS_BAR(); \
    } } while (0)
#define NSA_PL_LOAD(KR, VR, KB) do { KR = WSL(u32x4, kpt_ + (unsigned)(KB) * 8192u); VR = WSL(u32x4, vpt_ + (unsigned)(KB) * 8192u); } while (0)
#define NSA_PL_WRITE(KR, VR, PB, H) do { *(LAS u32x4*)(L_ + NK_OFF + (PB) + (H) * NSLOT + koff_) = KR; *(LAS u32x4*)(L_ + NV_OFF + (PB) + (H) * NSLOT + koff_) = VR; } while (0)
#define NSA_BLOCK_LOOP_PAIR(F, Kg_, Vg_, hi_, MAIN, LAST) do { \
    const int nb_ = (hi_); \
    LAS unsigned char* L_ = F.lds; const int row_ = F.tid >> 3, ch_ = F.tid & 7; const int koff_ = nsa_off(row_, ch_); \
    const unsigned kpt_ = (unsigned)(Kg_) + (row_ * 64u + 8u * ch_) * 2u, vpt_ = (unsigned)(Vg_) + (row_ * 64u + 8u * ch_) * 2u; \
    u32x4 k0r_, v0r_, k1r_ = (u32x4){0u, 0u, 0u, 0u}, v1r_ = (u32x4){0u, 0u, 0u, 0u}; \
    NSA_PL_LOAD(k0r_, v0r_, 0); if (1 <= nb_) NSA_PL_LOAD(k1r_, v1r_, 1); \
    NSA_PL_WRITE(k0r_, v0r_, 0u, 0); NSA_PL_WRITE(k1r_, v1r_, 0u, 1); \
    if (2 <= nb_) NSA_PL_LOAD(k0r_, v0r_, 2); if (3 <= nb_) NSA_PL_LOAD(k1r_, v1r_, 3); \
    LDS_BAR(); \
    for (int p_ = 0; p_ < nb_; p_ += 2) { \
        const unsigned pb_ = (p_ & 2) ? 4u * NSLOT : 0u; \
        { const int kb = p_; LAS unsigned char* Kb = L_ + NK_OFF + pb_; LAS unsigned char* Vb = L_ + NV_OFF + pb_; MAIN } \
        if (p_ + 1 >= nb_) break; \
        { const int kb = p_ + 1; LAS unsigned char* Kb = L_ + NK_OFF + pb_ + NSLOT; LAS unsigned char* Vb = L_ + NV_OFF + pb_ + NSLOT; MAIN } \
        NSA_PL_WRITE(k0r_, v0r_, pb_ ^ (4u * NSLOT), 0); NSA_PL_WRITE(k1r_, v1r_, pb_ ^ (4u * NSLOT), 1); \
        if (p_ + 4 <= nb_) NSA_PL_LOAD(k0r_, v0r_, p_ + 4); if (p_ + 5 <= nb_) NSA_PL_LOAD(k1r_, v1r_, p_ + 5); \
        LDS_BAR(); \
    } \
    { const int kb = nb_; const unsigned pl_ = ((nb_ & 2) ? 4u * NSLOT : 0u) + (unsigned)(nb_ & 1) * NSLOT; LAS unsigned char* Kb = L_ + NK_OFF + pl_; LAS unsigned char* Vb = L_ + NV_OFF + pl_; LAST } \
    LDS_BAR(); \
    } while (0)
#define NSA_TL_WRITE(KR, VR, SB, H) do { *(LAS u32x4*)(L_ + (SB) + (H) * NSLOT + koff_) = KR; *(LAS u32x4*)(L_ + (SB) + 3 * NSLOT + (H) * NSLOT + koff_) = VR; } while (0)
#define NSA_BLOCK_LOOP_TRI(F, Kg_, Vg_, hi_, MAIN, LAST) do { \
    const int nb_ = (hi_); \
    LAS unsigned char* L_ = F.lds; const int row_ = F.tid >> 3, ch_ = F.tid & 7; const int koff_ = nsa_off(row_, ch_); \
    const unsigned kpt_ = (unsigned)(Kg_) + (row_ * 64u + 8u * ch_) * 2u, vpt_ = (unsigned)(Vg_) + (row_ * 64u + 8u * ch_) * 2u; \
    u32x4 k0r_, v0r_, k1r_ = (u32x4){0u, 0u, 0u, 0u}, v1r_ = (u32x4){0u, 0u, 0u, 0u}, k2r_ = (u32x4){0u, 0u, 0u, 0u}, v2r_ = (u32x4){0u, 0u, 0u, 0u}; \
    NSA_PL_LOAD(k0r_, v0r_, 0); if (1 <= nb_) NSA_PL_LOAD(k1r_, v1r_, 1); if (2 <= nb_) NSA_PL_LOAD(k2r_, v2r_, 2); \
    LDS_BAR(); \
    NSA_TL_WRITE(k0r_, v0r_, 0u, 0); NSA_TL_WRITE(k1r_, v1r_, 0u, 1); NSA_TL_WRITE(k2r_, v2r_, 0u, 2); \
    if (3 <= nb_) NSA_PL_LOAD(k0r_, v0r_, 3); if (4 <= nb_) NSA_PL_LOAD(k1r_, v1r_, 4); if (5 <= nb_) NSA_PL_LOAD(k2r_, v2r_, 5); \
    LDS_BAR(); \
    unsigned sb_ = 0u; int p_ = 0; \
    for (; ; p_ += 3) { \
        if (p_ >= nb_) break; \
        { const int kb = p_; LAS unsigned char* Kb = L_ + sb_; LAS unsigned char* Vb = L_ + sb_ + 3 * NSLOT; MAIN } \
        if (p_ + 1 >= nb_) break; \
        { const int kb = p_ + 1; LAS unsigned char* Kb = L_ + sb_ + NSLOT; LAS unsigned char* Vb = L_ + sb_ + 4 * NSLOT; MAIN } \
        if (p_ + 2 >= nb_) break; \
        { const int kb = p_ + 2; LAS unsigned char* Kb = L_ + sb_ + 2 * NSLOT; LAS unsigned char* Vb = L_ + sb_ + 5 * NSLOT; MAIN } \
        sb_ ^= 6u * NSLOT; \
        NSA_TL_WRITE(k0r_, v0r_, sb_, 0); NSA_TL_WRITE(k1r_, v1r_, sb_, 1); NSA_TL_WRITE(k2r_, v2r_, sb_, 2); \
        if (p_ + 6 <= nb_) NSA_PL_LOAD(k0r_, v0r_, p_ + 6); if (p_ + 7 <= nb_) NSA_PL_LOAD(k1r_, v1r_, p_ + 7); if (p_ + 8 <= nb_) NSA_PL_LOAD(k2r_, v2r_, p_ + 8); \
        LDS_BAR(); \
    } \
    { const int kb = nb_; const unsigned pl_ = sb_ + (unsigned)(nb_ - p_) * NSLOT; LAS unsigned char* Kb = L_ + pl_; LAS unsigned char* Vb = L_ + pl_ + 3 * NSLOT; LAST } \
    LDS_BAR(); \
    } while (0)
#define NSA_BL_LOAD(KR, VR, KB) do { KR = WSL(u32x4, kpt_ + (unsigned)((KB) - kb_lo_) * kst_); if (hasV__) VR = WSL(u32x4, vpt_ + vbs_ * (unsigned)((KB) - kb_lo_)); } while (0)
#define NSA_BL_WRITE(KR, VR, BS) do { *(LAS u32x4*)(L_ + NK_OFF + (BS) * NSLOT + koff_) = KR; if (hasV__) *(LAS u32x4*)(L_ + NV_OFF + (BS) * NSLOT + koff_) = VR; } while (0)
__device__ __forceinline__ unsigned row_max16(unsigned x) {
#define RM_(CTRL) { const unsigned t_ = (unsigned)__builtin_amdgcn_update_dpp(0, (int)x, CTRL, 0xF, 0xF, false); x = x > t_ ? x : t_; }
    RM_(0xB1) RM_(0x4E) RM_(0x124) RM_(0x128)
#undef RM_
    return x;
}
__device__ __forceinline__ void nsa_topk2(LAS float* IA, LAS float* IB, int cur, int lane, int qi, unsigned& ma0, unsigned& ma1, unsigned& ma2, unsigned& ma3, unsigned& mb0, unsigned& mb1, unsigned& mb2, unsigned& mb3) {
    const int tqi = lane >> 4, sub = lane & 15; unsigned ka[8], kb2[8];
#pragma unroll
    for (int e = 0; e < 8; ++e) { const int j = sub * 8 + e; const bool ok = (j >= 1) && (j <= cur - 1);
        const float va = IA[tqi * 128 + j] + ((j >= 1) ? IB[tqi * 128 + j - 1] : 0.f), vb = IA[512 + tqi * 128 + j] + ((j >= 1) ? IB[512 + tqi * 128 + j - 1] : 0.f);
        ka[e] = ok ? ((__builtin_bit_cast(unsigned, va) & ~127u) | (unsigned)(127 - j)) : 0u; kb2[e] = ok ? ((__builtin_bit_cast(unsigned, vb) & ~127u) | (unsigned)(127 - j)) : 0u; }
    unsigned a0 = 0u, a1 = 0u, a2 = 0u, a3 = 0u, b0 = 0u, b1 = 0u, b2 = 0u, b3 = 0u;
    for (int rnd = 0; rnd < 14; ++rnd) {
        unsigned la = ka[0], lb = kb2[0];
#pragma unroll
        for (int e = 1; e < 8; ++e) { la = la > ka[e] ? la : ka[e]; lb = lb > kb2[e] ? lb : kb2[e]; }
        const unsigned ga = row_max16(la), gb = row_max16(lb);
#pragma unroll
        for (int e = 0; e < 8; ++e) { ka[e] = (ka[e] == ga) ? 0u : ka[e]; kb2[e] = (kb2[e] == gb) ? 0u : kb2[e]; }
        const int ja = 127 - (int)(ga & 127u), jb = 127 - (int)(gb & 127u); const unsigned ba = ga ? (1u << (ja & 31)) : 0u, bb = gb ? (1u << (jb & 31)) : 0u; const int wa = ja >> 5, wb = jb >> 5;
        a0 |= (wa == 0) ? ba : 0u; a1 |= (wa == 1) ? ba : 0u; a2 |= (wa == 2) ? ba : 0u; a3 |= (wa == 3) ? ba : 0u;
        b0 |= (wb == 0) ? bb : 0u; b1 |= (wb == 1) ? bb : 0u; b2 |= (wb == 2) ? bb : 0u; b3 |= (wb == 3) ? bb : 0u;
    }
    { const unsigned bit = 1u << (cur & 31); const int wc = cur >> 5; const unsigned c0 = ((wc == 0) ? bit : 0u) | 1u, c1 = (wc == 1) ? bit : 0u, c2 = (wc == 2) ? bit : 0u, c3 = (wc == 3) ? bit : 0u;
      a0 |= c0; a1 |= c1; a2 |= c2; a3 |= c3; b0 |= c0; b1 |= c1; b2 |= c2; b3 |= c3; }
    const int src = 16 * qi;
    ma0 = (unsigned)__shfl((int)a0, src); ma1 = (unsigned)__shfl((int)a1, src); ma2 = (unsigned)__shfl((int)a2, src); ma3 = (unsigned)__shfl((int)a3, src);
    mb0 = (unsigned)__shfl((int)b0, src); mb1 = (unsigned)__shfl((int)b1, src); mb2 = (unsigned)__shfl((int)b2, src); mb3 = (unsigned)__shfl((int)b3, src);
}
template <bool SAFE>
__device__ __forceinline__ bool nsa_item_wg(Frame& F1, int item) {
    Frame F = F1; asm volatile("" : "+v"(F.tid), "+v"(F.lane));
    const int lane = F.lane, w = F.wave, c = lane & 15, g = lane >> 4, qi = c >> 2, hh = c & 3;
    const int bg = item & 7, b = bg >> 1, g2 = bg & 1, t0w = (127 - (item >> 3)) * 64, t0 = t0w + 8 * w, tqa = t0 + qi, tqb = t0 + 4 + qi, cur = t0w >> 6;
    const unsigned toka = (unsigned)(b * SEQ + tqa), tokb = toka + 4u;
#define WSL(T, OFF) (*(const GAS T*)(F.wsb + (size_t)(unsigned)(OFF)))
#define WSS(T, OFF) (*(GAS T*)(F.wsb + (size_t)(unsigned)(OFF)))
    LAS float* wscr = (LAS float*)(F.lds + NI_OFF + w * 8192); LAS float* IA = wscr; LAS float* IB = wscr + 1024;
    AttnSt sa, sb; bool bad = false;
    const unsigned nga = (unsigned)WS_ZA + (toka * ZP + C_NG + g2 * 4 + hh) * 2u, ngb = nga + 4u * ZP * 2u;
    const unsigned opa = (unsigned)WS_XN + (toka * 1024u + (4 * g2 + hh) * 64 + 4 * g) * 2u, opb = opa + 4u * 1024u * 2u;
    LAS unsigned char* accp = F.lds + NACC_OFF + w * 4096 + lane * 8;
#define NSA_FLUSH(MODE, GA, GB) do { _Pragma("unroll") for (int dt = 0; dt < 4; ++dt) { f32x4 o1 = sa.o[dt] * (GA), o2 = sb.o[dt] * (GB); \
        if ((MODE) != 0) { const u32x2 p1 = *(const LAS u32x2*)(accp + (2 * dt) * 512), p2 = *(const LAS u32x2*)(accp + (2 * dt + 1) * 512); o1 = o1 + (f32x4){bflo(p1.x), bfhi(p1.x), bflo(p1.y), bfhi(p1.y)}; o2 = o2 + (f32x4){bflo(p2.x), bfhi(p2.x), bflo(p2.y), bfhi(p2.y)}; } \
        u32x2 w1; w1.x = cvtpk(o1[0], o1[1]); w1.y = cvtpk(o1[2], o1[3]); u32x2 w2; w2.x = cvtpk(o2[0], o2[1]); w2.y = cvtpk(o2[2], o2[3]); \
        if ((MODE) == 2) { WSS(u32x2, opa + 32 * dt) = w1; WSS(u32x2, opb + 32 * dt) = w2; } else { *(LAS u32x2*)(accp + (2 * dt) * 512) = w1; *(LAS u32x2*)(accp + (2 * dt + 1) * 512) = w2; } } } while (0)
    {
        attn_init(sa); sa.m = 0.f; attn_init(sb); sb.m = 0.f;
_Pragma("unroll")
        for (int e = 0; e < 32; ++e) wscr[e * 64 + lane] = 0.f;
        const unsigned qpa = (unsigned)WS_ZA + (toka * ZP + (4 * g2 + hh) * 64 + 8 * g) * 2u, qpb = qpa + 4u * ZP * 2u;
        const bf16x8 qa0 = WSL(bf16x8, qpa), qa1 = WSL(bf16x8, qpa + 64), qb0 = WSL(bf16x8, qpb), qb1 = WSL(bf16x8, qpb + 64);
        const int nmaxa = (tqa >= 31) ? ((tqa - 31) >> 4) : -1, nmaxb = (tqb >= 31) ? ((tqb - 31) >> 4) : -1, nkb = (((t0w + 32) >> 4) >> 6) + 1;
        const int nmin = (t0 >= 31) ? ((t0 - 31) >> 4) : -1;
        const unsigned KCb = (unsigned)WS_KC + (unsigned)bg * 512u * 64u * 2u, VCTb = (unsigned)WS_VCT + (unsigned)bg * 64u * 512u * 2u;
        NSA_BLOCK_LOOP(F, KCb, 64, VCTb, 512, false, 0, nkb - 1, {
            if (64 * kb + 63 <= nmin) attn_block2g<SAFE, false, false>(sa, sb, qa0, qa1, qb0, qb1, Kb, Vb, c, g, true, true, true, true, [=](int off) { return true; }, [=](int off) { return true; });
            else attn_block2g<SAFE, true, false>(sa, sb, qa0, qa1, qb0, qb1, Kb, Vb, c, g, true, true, true, true, [=](int off) { return (64 * kb + off) <= nmaxa; }, [=](int off) { return (64 * kb + off) <= nmaxb; }); });
        float l1a = sa.l; l1a += __shfl_xor(l1a, 16); l1a += __shfl_xor(l1a, 32); float l1b = sb.l; l1b += __shfl_xor(l1b, 16); l1b += __shfl_xor(l1b, 32);
        if (!SAFE) bad = bad || !(l1a < 1e30f) || !(l1b < 1e30f);
        const float ila = (l1a > 0.f) ? 1.0f / l1a : 0.f, ilb = (l1b > 0.f) ? 1.0f / l1b : 0.f; const float m1a = sa.m, m1b = sb.m;
        NSA_BLOCK_LOOP(F, KCb, 64, VCTb, 512, true, 0, nkb - 1, {
            f32x4 pa[4], pb[4];
_Pragma("unroll")
            for (int kt = 0; kt < 4; ++kt) { const bf16x8 k0 = *(const LAS bf16x8*)(Kb + nsa_off(16 * kt + c, g)), k1 = *(const LAS bf16x8*)(Kb + nsa_off(16 * kt + c, 4 + g)); const f32x4 z = (f32x4){0.f, 0.f, 0.f, 0.f};
                pa[kt] = __builtin_amdgcn_mfma_f32_16x16x32_bf16(k0, qa0, z, 0, 0, 0); pb[kt] = __builtin_amdgcn_mfma_f32_16x16x32_bf16(k0, qb0, z, 0, 0, 0);
                pa[kt] = __builtin_amdgcn_mfma_f32_16x16x32_bf16(k1, qa1, pa[kt], 0, 0, 0); pb[kt] = __builtin_amdgcn_mfma_f32_16x16x32_bf16(k1, qb1, pb[kt], 0, 0, 0); }
_Pragma("unroll")
            for (int kt = 0; kt < 4; ++kt) {
_Pragma("unroll")
                for (int r = 0; r < 4; ++r) { const int n = 64 * kb + 16 * kt + 4 * g + r; pa[kt][r] = (n <= nmaxa) ? fast_exp2(SAFE ? pa[kt][r] - m1a : pa[kt][r]) : 0.f; pb[kt][r] = (n <= nmaxb) ? fast_exp2(SAFE ? pb[kt][r] - m1b : pb[kt][r]) : 0.f; }
                float s4a = ((pa[kt][0] + pa[kt][1]) + (pa[kt][2] + pa[kt][3])) * ila, p3a = pa[kt][3] * ila, s4b = ((pb[kt][0] + pb[kt][1]) + (pb[kt][2] + pb[kt][3])) * ilb, p3b = pb[kt][3] * ilb;
                s4a += __shfl_xor(s4a, 1); s4a += __shfl_xor(s4a, 2); p3a += __shfl_xor(p3a, 1); p3a += __shfl_xor(p3a, 2);
                s4b += __shfl_xor(s4b, 1); s4b += __shfl_xor(s4b, 2); p3b += __shfl_xor(p3b, 1); p3b += __shfl_xor(p3b, 2);
                if (hh == 0) { const int j = 16 * kb + 4 * kt + g; IA[qi * 128 + j] = s4a; IB[qi * 128 + j] = p3a; IA[(4 + qi) * 128 + j] = s4b; IB[(4 + qi) * 128 + j] = p3b; } }
            pv_block_lds(sa.o, pa, Vb, c, g); pv_block_lds(sb.o, pb, Vb, c, g); });
        const float gca = sigmoidf_(bf2f(WSL(bf16_t, nga))), gcb = sigmoidf_(bf2f(WSL(bf16_t, ngb)));
        NSA_FLUSH(0, gca * ila, gcb * ilb);
    }
    LDS_WAIT(); asm volatile("" ::: "memory");
    unsigned ma0 = 0u, ma1 = 0u, ma2 = 0u, ma3 = 0u, mb0 = 0u, mb1 = 0u, mb2 = 0u, mb3 = 0u;
    if (cur <= 15) { ma0 = (1u << (cur + 1)) - 1u; mb0 = ma0; }
    else nsa_topk2(IA, IB, cur, lane, qi, ma0, ma1, ma2, ma3, mb0, mb1, mb2, mb3);
    const unsigned qpa = (unsigned)WS_QR + (toka * 512u + (4 * g2 + hh) * 64 + 8 * g) * 2u, qpb = qpa + 4u * 512u * 2u;
    const bf16x8 qa0 = WSL(bf16x8, qpa), qa1 = WSL(bf16x8, qpa + 64), qb0 = WSL(bf16x8, qpb), qb1 = WSL(bf16x8, qpb + 64);
    {
        attn_init(sa); sa.m = 0.f; attn_init(sb); sb.m = 0.f;
        unsigned mwa = 0u, mwb = 0u;
#define SEL_NEED_ if ((kb & 31) == 0) { mwa = kb < 32 ? ma0 : kb < 64 ? ma1 : kb < 96 ? ma2 : ma3; mwb = kb < 32 ? mb0 : kb < 64 ? mb1 : kb < 96 ? mb2 : mb3; } const unsigned wa = mwa, wb = mwb; \
            const bool needA = (wa >> (kb & 31)) & 1u, needB = (wb >> (kb & 31)) & 1u; const bool doA = __ballot(needA) != 0ull, doB = __ballot(needB) != 0ull;
#define SEL_MAIN_ { SEL_NEED_ if (SAFE || (doA && doB)) { if (doA || doB) attn_block2g<SAFE, false, true>(sa, sb, qa0, qa1, qb0, qb1, Kb, Vb, c, g, needA, needB, doA, doB, [=](int off) { return true; }, [=](int off) { return true; }); } \
            else if (doA) attn_block1g(sa, qa0, qa1, Kb, Vb, c, g, needA); else if (doB) attn_block1g(sb, qb0, qb1, Kb, Vb, c, g, needB); }
#define SEL_LAST_ { SEL_NEED_ const int lima = tqa - 64 * kb, limb = tqb - 64 * kb; \
            attn_block2g<SAFE, true, true>(sa, sb, qa0, qa1, qb0, qb1, Kb, Vb, c, g, needA, needB, doA, doB, [=](int off) { return off <= lima; }, [=](int off) { return off <= limb; }); }
        NSA_BLOCK_LOOP_TRI(F, (unsigned)WS_KSB + (unsigned)bg * SEQ * 64u * 2u, (unsigned)WS_VST + (unsigned)bg * 64u * SEQ * 2u, cur, SEL_MAIN_, SEL_LAST_);
#undef SEL_NEED_
#undef SEL_MAIN_
#undef SEL_LAST_
        float la = sa.l; la += __shfl_xor(la, 16); la += __shfl_xor(la, 32); float lb = sb.l; lb += __shfl_xor(lb, 16); lb += __shfl_xor(lb, 32);
        if (!SAFE) bad = bad || !(la < 1e30f) || !(lb < 1e30f);
        const float gsa = (la > 0.f) ? sigmoidf_(bf2f(WSL(bf16_t, nga + 16))) / la : 0.f, gsb = (lb > 0.f) ? sigmoidf_(bf2f(WSL(bf16_t, ngb + 16))) / lb : 0.f;
        NSA_FLUSH(1, gsa, gsb);
    }
    {
        attn_init(sa); sa.m = 0.f; attn_init(sb); sb.m = 0.f;
        NSA_BLOCK_LOOP(F, (unsigned)WS_KWB + (unsigned)bg * SEQ * 64u * 2u, 64, (unsigned)WS_VWT + (unsigned)bg * 64u * SEQ * 2u, 64, true, (cur >= 8) ? cur - 8 : 0, cur, {
            const int lima = tqa - 64 * kb, limb = tqb - 64 * kb, lim0 = t0 - 64 * kb;
            if (lim0 + 7 >= 0 && lim0 - 512 < 63) {
                if (lim0 >= 63 && lim0 + 7 - 512 < 0) attn_block2g<SAFE, false, true>(sa, sb, qa0, qa1, qb0, qb1, Kb, Vb, c, g, true, true, true, true, [=](int off) { return true; }, [=](int off) { return true; });
                else attn_block2g<SAFE, true, true>(sa, sb, qa0, qa1, qb0, qb1, Kb, Vb, c, g, true, true, true, true, [=](int off) { return (off <= lima) && (off > lima - 512); }, [=](int off) { return (off <= limb) && (off > limb - 512); }); } });
        float la = sa.l; la += __shfl_xor(la, 16); la += __shfl_xor(la, 32); float lb = sb.l; lb += __shfl_xor(lb, 16); lb += __shfl_xor(lb, 32);
        if (!SAFE) bad = bad || !(la < 1e30f) || !(lb < 1e30f);
        const float gwa = (la > 0.f) ? sigmoidf_(bf2f(WSL(bf16_t, nga + 32))) / la : 0.f, gwb = (lb > 0.f) ? sigmoidf_(bf2f(WSL(bf16_t, ngb + 32))) / lb : 0.f;
        NSA_FLUSH(2, gwa, gwb);
    }
    return __ballot(bad) != 0ull;
}
#undef NSA_FLUSH
__device__ __forceinline__ void nsa_phase(Frame& F0) {
    PHASE_FRAME(F, F0);
    LAS int* slot = (LAS int*)(F.lds + NQ_OFF); const int myq = (int)(xb_xcc_id() & 7u);
    __syncthreads();
    for (int qq = 0; qq < 8; ++qq) {
        const int q = (myq + qq) & 7; unsigned* head = F.ctl + CW_Q_NSA + 64 * q;
        for (;;) {
            if (F.tid == 0) { *slot = (int)__hip_atomic_fetch_add(head, 1u, RLX_AGENT); slot[1] = 0; }
            __syncthreads();
            const int idx = __builtin_amdgcn_readfirstlane(*slot);
            __syncthreads();
            if (idx >= 128) break;
            const bool bad = nsa_item_wg<false>(F, (idx << 3) | q);
            if (bad && F.lane == 0) slot[1] = 1;
            __syncthreads();
            const int redo = __builtin_amdgcn_readfirstlane(slot[1]);
            __syncthreads();
            if (redo) nsa_item_wg<true>(F, (idx << 3) | q);
        }
    }
}

__device__ __forceinline__ void row_pass1(Frame& F0, const bf16_t* MIX, bf16_t* H2, bf16_t* X1B) {
    PHASE_FRAME(F, F0);
    const int lane = F.lane; f32x4 g1[4], g2[4];
#pragma unroll
    for (int j = 0; j < 4; ++j) { g1[j] = ((const f32x4*)F.A.in[(I_N1POST) + F.z])[lane + 64 * j]; g2[j] = ((const f32x4*)F.A.in[(I_N2PRE) + F.z])[lane + 64 * j]; }
    for (int m = F.gw; m < NTOK; m += F.NGW) {
        const u32x2* mr = (const u32x2*)(MIX + (size_t)m * DM) + lane; const f32x4* xr = (const f32x4*)(F.A.in[(I_X) + F.z] + (size_t)m * DM) + lane; f32x4 v[4], x[4]; float s = 0.f;
#pragma unroll
        for (int j = 0; j < 4; ++j) { const u32x2 mw = mr[64 * j]; v[j] = (f32x4){bflo(mw.x), bfhi(mw.x), bflo(mw.y), bfhi(mw.y)}; x[j] = xr[64 * j]; s += (v[j].x * v[j].x + v[j].y * v[j].y) + (v[j].z * v[j].z + v[j].w * v[j].w); }
        const float rs = 1.0f / sqrtf(wave_sum(s) * (1.f / DM) + 1e-6f); float s2 = 0.f;
        u32x2* orow = (u32x2*)(X1B + (size_t)m * DM) + lane;
#pragma unroll
        for (int j = 0; j < 4; ++j) { x[j] = x[j] + v[j] * rs * g1[j]; { u32x2 w1; w1.x = cvtpk(x[j].x, x[j].y); w1.y = cvtpk(x[j].z, x[j].w); orow[64 * j] = w1; } s2 += (x[j].x * x[j].x + x[j].y * x[j].y) + (x[j].z * x[j].z + x[j].w * x[j].w); }
        const float rs2 = 1.0f / sqrtf(wave_sum(s2) * (1.f / DM) + 1e-6f);
        u32x2* o8 = (u32x2*)(H2 + (size_t)m * DM) + lane;
#pragma unroll
        for (int j = 0; j < 4; ++j) { u32x2 w; w.x = cvtpk(x[j].x * rs2 * g2[j].x, x[j].y * rs2 * g2[j].y); w.y = cvtpk(x[j].z * rs2 * g2[j].z, x[j].w * rs2 * g2[j].w); o8[64 * j] = w; }
    }
}
__device__ __forceinline__ void row_pass2(Frame& F0, const bf16_t* Fm, const bf16_t* X1B) {
    PHASE_FRAME(F, F0);
    const int lane = F.lane; f32x4 g1[4];
#pragma unroll
    for (int j = 0; j < 4; ++j) g1[j] = ((const f32x4*)F.A.in[(I_N2POST) + F.z])[lane + 64 * j];
    for (int m = F.gw; m < NTOK; m += F.NGW) {
        const u32x2* mr = (const u32x2*)(Fm + (size_t)m * DM) + lane; f32x4* orow = (f32x4*)(F.A.out + (size_t)m * DM) + lane; const u32x2* xr = (const u32x2*)(X1B + (size_t)m * DM) + lane; f32x4 v[4], x[4]; float s = 0.f;
#pragma unroll
        for (int j = 0; j < 4; ++j) { const u32x2 mw = mr[64 * j]; v[j] = (f32x4){bflo(mw.x), bfhi(mw.x), bflo(mw.y), bfhi(mw.y)}; const u32x2 xw = xr[64 * j]; x[j] = (f32x4){bflo(xw.x), bfhi(xw.x), bflo(xw.y), bfhi(xw.y)}; s += (v[j].x * v[j].x + v[j].y * v[j].y) + (v[j].z * v[j].z + v[j].w * v[j].w); }
        const float rs = 1.0f / sqrtf(wave_sum(s) * (1.f / DM) + 1e-6f);
#pragma unroll
        for (int j = 0; j < 4; ++j) orow[64 * j] = x[j] + v[j] * rs * g1[j];
    }
}

__global__ void __launch_bounds__(NWAVES * 64, 2) hybrid_fwd(Args args) {
    extern __shared__ __attribute__((aligned(16))) unsigned char lds[];
    Frame F{args};
    F.lds = (LAS unsigned char*)lds; F.MISC = (volatile LAS unsigned*)(F.lds + MISC_OFF);
    F.tid = threadIdx.x; F.lane = F.tid & 63; F.wave = __builtin_amdgcn_readfirstlane(F.tid >> 6);
    F.G = gridDim.x; { const int bx = blockIdx.x; F.vcu = (F.G % 8 == 0) ? (bx % 8) * (F.G / 8) + bx / 8 : bx; }
    F.gw = F.vcu * NWAVES + F.wave; F.NGW = F.G * NWAVES;
    unsigned char* ws = args.ws; F.ctl = (unsigned*)(ws + WS_CTL); F.z = 0; F.wsb = (GAS unsigned char*)ws;
    for (int u = F.tid; u < (LDS_BYTES - LDSCTL_OFF) / 4; u += NWAVES * 64) ((LAS unsigned*)(F.lds + LDSCTL_OFF))[u] = 0u;
    __syncthreads();
    XcdBarrier bar = xcd_barrier_post(F.ctl + CW_BAR, F.MISC + 8);
#define GRID_BAR() xcd_barrier(bar)
    const int G = F.G, bx = (int)blockIdx.x;

    p0_prologue(F); GRID_BAR();
    { pg8::Gemm g{1024, 1024, 128u, -1}; pg8::StaticOrder S; S.init(((bf16_t*)(F.wsb + WS_XN)), ((bf16_t*)(F.wsb + WS_WIN)), NTOK, 5120, 1024, 1024, G, bx);
      EpiZ E{((bf16_t*)(F.wsb + WS_ZA)), ((bf16_t*)(F.wsb + WS_MG)), ((bf16_t*)(F.wsb + WS_QR)), ((bf16_t*)(F.wsb + WS_VST)), ((bf16_t*)(F.wsb + WS_VWT)), ((bf16_t*)(F.wsb + WS_KSB)), ((bf16_t*)(F.wsb + WS_KWB)), ((float*)(F.wsb + WS_ROPE))};
      pg8::gemm_phase(F.lds, g, S, E); GRID_BAR(); }
    { pg8::Gemm g{2048, 16 * ZP, (unsigned)(ZP * 2), -1}; CmpOrder S{F.vcu, ((bf16_t*)(F.wsb + WS_ZA)), ((bf16_t*)(F.wsb + WS_W1K)), ((bf16_t*)(F.wsb + WS_W1V))}; EpiCmp E{((bf16_t*)(F.wsb + WS_HID)), ((float*)(F.wsb + WS_B1P))};
      pg8::gemm_phase(F.lds, g, S, E);
      if (F.vcu < 32) { VM_WAIT(); __syncthreads(); cmp_stage2(F, F.vcu); } }
    rwkv_chunk_phase(F, (unsigned char*)args.out);
    deferred_transposes(F);
    GRID_BAR();
    if ((F.vcu & 31) >= 28) rwkv_scan_serial(F, (const unsigned char*)args.out, (F.vcu >> 5) * 4 + (F.vcu & 3));
    nsa_phase(F);
    rwkv_post(F);
    GRID_BAR();
    bf16_t* MIXP = (bf16_t*)(ws + WS_ZA + 128 * MiB); bf16_t* MIX = (bf16_t*)(ws + WS_ZA + 64 * MiB); bf16_t* ACT = (bf16_t*)(ws + WS_ZA); bf16_t* FM = (bf16_t*)(ws + WS_MG); bf16_t* H2 = ((bf16_t*)(F.wsb + WS_XN));
    { pg8::Gemm g{512, 1024, 128u, -1}; pg8::TwoPartOrder S; S.S.init(((bf16_t*)(F.wsb + WS_XN)), ((bf16_t*)(F.wsb + WS_WA)), NTOK, 1024, 512, 1024, G, bx); S.a2off = 1024; S.b2off = (size_t)1024 * 512 * 2; EpiMerge E{((bf16_t*)(F.wsb + WS_MG)), MIXP};
      pg8::gemm_phase(F.lds, g, S, E); GRID_BAR(); }
    { pg8::Gemm g{1024, 1024, 128u, -1}; pg8::StaticOrder S; S.init(MIXP, ((bf16_t*)(F.wsb + WS_WOUT)), NTOK, 1024, 1024, 1024, G, bx); EpiBf16Plain E{MIX, 1024};
      pg8::gemm_phase(F.lds, g, S, E); GRID_BAR(); }
    bf16_t* X1B = (bf16_t*)(ws + WS_MG + 64 * MiB);
    row_pass1(F, MIX, H2, X1B); GRID_BAR();
    { pg8::Gemm g{1024, 1024, 128u, -1}; pg8::StaticOrder S; S.init(H2, ((bf16_t*)(F.wsb + WS_WGU)), NTOK, 2 * DFF, 1024, 1024, G, bx); EpiSwiGLU E{ACT};
      pg8::gemm_phase(F.lds, g, S, E); GRID_BAR(); }
    { pg8::Gemm g{DFF, DFF, 128u, -1}; pg8::StaticOrder S; S.init(ACT, ((bf16_t*)(F.wsb + WS_WD)), NTOK, 1024, DFF, DFF, G, bx); EpiBf16Plain E{FM, 1024};
      pg8::gemm_phase(F.lds, g, S, E); GRID_BAR(); }
    row_pass2(F, FM, X1B);
}

extern "C" void kernel_launch(void* const* d_in, const int* in_sizes, int n_in, void* d_out, int out_size, void* d_ws, size_t ws_size, hipStream_t stream) {
    static int grid = 0;
    if (grid == 0) {
        if (n_in != 36 || out_size != NTOK * DM || ws_size < WS_END) { fprintf(stderr, "kernel_launch: unexpected shapes (n_in %d out %d ws %zu)\n", n_in, out_size, ws_size); grid = -1; return; }
        int dev = 0, cus = 0;
        if (hipGetDevice(&dev) != hipSuccess || hipDeviceGetAttribute(&cus, hipDeviceAttributeMultiprocessorCount, dev) != hipSuccess) { grid = -1; return; }
        if (hipFuncSetAttribute((const void*)hybrid_fwd, hipFuncAttributeMaxDynamicSharedMemorySize, LDS_BYTES) != hipSuccess) { fprintf(stderr, "kernel_launch: hipFuncSetAttribute failed\n"); grid = -1; return; }
        int per_cu = 0; (void)hipOccupancyMaxActiveBlocksPerMultiprocessor(&per_cu, (const void*)hybrid_fwd, NWAVES * 64, LDS_BYTES); (void)hipGetLastError();
        grid = cus;
        if (grid != 256) fprintf(stderr, "kernel_launch: grid %d (expected 256)\n", grid);
    }
    if (grid < 0) return;
    (void)hipMemsetAsync((char*)d_ws + WS_CTL, 0, CTL_ZERO_BYTES, stream);
    Args a{};
    for (int i = 0; i < 36; ++i) a.in[i] = (const float*)d_in[i];
    a.out = (float*)d_out; a.ws = (unsigned char*)d_ws;
    hipLaunchKernelGGL(hybrid_fwd, dim3(grid), dim3(NWAVES * 64), LDS_BYTES, stream, a);
}
```
